# Optimizing an MI355X kernel written in HIP

```python
import jax, jax.numpy as jnp
from jax import lax
import numpy as np

D_MODEL = 2048
BATCH = 2
SEQ = 16384
DEPTH = 2

N_A_LAYERS = DEPTH // 2
N_B_LAYERS = DEPTH - N_A_LAYERS

MLA_HEADS = 16
Q_LORA = 512
KV_LORA = 512
QK_NOPE = 128
QK_ROPE = 64
QK_HEAD = QK_NOPE + QK_ROPE
V_HEAD = 128
MLA_WIDTH = MLA_HEADS * V_HEAD
A_IN_COLS = Q_LORA + KV_LORA + QK_ROPE + MLA_WIDTH
ROPE_THETA = 10000.0
Q_BLOCK = 128

DIL_GROUPS = ((128, 1), (512, 4), (2048, 16))
N_GROUPS = 3
DIL_HEADS = 16
DIL_HEAD_DIM = 128
DIL_WIDTH = DIL_HEADS * DIL_HEAD_DIM
B_Q_COLS = N_GROUPS * DIL_WIDTH
B_IN_COLS = B_Q_COLS + DIL_WIDTH
KV_SHARED_COLS = 2 * N_GROUPS * DIL_WIDTH
LOOKBACK = 128
BAND_BLK = 128
ALIBI_MAX = 8.0

EPS = 1e-6
NEG_INF = -1e30

kernel_name = "yoco_mla_dilated_alibi_hybrid"


def rms_norm(x, g):
    xf = x.astype(jnp.float32)
    y = xf * lax.rsqrt(jnp.mean(xf * xf, axis=-1, keepdims=True) + EPS)
    return y.astype(x.dtype) * g


def rope(x, pos):
    half = QK_ROPE // 2
    inv = ROPE_THETA ** (-jnp.arange(half, dtype=jnp.float32) / half)
    ang = pos.astype(jnp.float32)[:, None] * inv[None, :]
    cos = jnp.cos(ang)[None, :, None, :]
    sin = jnp.sin(ang)[None, :, None, :]
    x1 = x[..., :half].astype(jnp.float32)
    x2 = x[..., half:].astype(jnp.float32)
    out = jnp.concatenate([x1 * cos - x2 * sin, x2 * cos + x1 * sin], axis=-1)
    return out.astype(x.dtype)


def causal_dense_attention(q, k, v):
    B, S, H, E = q.shape
    nb = S // Q_BLOCK
    scale = E ** -0.5
    kpos = jnp.arange(S)

    def one_block(i):
        start = i * Q_BLOCK
        qb = lax.dynamic_slice_in_dim(q, start, Q_BLOCK, axis=1)
        s = jnp.einsum('bqhe,bkhe->bhqk', qb, k, preferred_element_type=jnp.float32) * scale
        qpos = start + jnp.arange(Q_BLOCK)
        s = jnp.where(kpos[None, :] <= qpos[:, None], s, NEG_INF)
        p = jax.nn.softmax(s, axis=-1)
        return jnp.einsum('bhqk,bkhd->bqhd', p.astype(v.dtype), v)

    o = lax.map(one_block, jnp.arange(nb))
    return jnp.moveaxis(o, 0, 1).reshape(B, S, H, v.shape[-1]).astype(q.dtype)


def dilated_group_attention(q, k, v, dilation, slopes):
    B, S, H, E = q.shape
    L = S // dilation
    nb = -(-L // BAND_BLK)
    Lp = nb * BAND_BLK

    def strided(a, front):
        a = a.reshape(B, L, dilation, H, E).transpose(0, 2, 1, 3, 4)
        return jnp.pad(a, ((0, 0), (0, 0), (front, Lp - L), (0, 0), (0, 0)))

    qs = strided(q, 0).reshape(B, dilation, nb, BAND_BLK, H, E)
    kp = strided(k, BAND_BLK)
    vp = strided(v, BAND_BLK)

    def band(a):
        prev = a[:, :, :Lp].reshape(B, dilation, nb, BAND_BLK, H, E)
        cur = a[:, :, BAND_BLK:].reshape(B, dilation, nb, BAND_BLK, H, E)
        return jnp.concatenate([prev, cur], axis=3)

    kb, vb = band(kp), band(vp)
    s = jnp.einsum('brnqhe,brnkhe->brnhqk', qs, kb, preferred_element_type=jnp.float32)
    rel = jnp.arange(BAND_BLK)[:, None] + BAND_BLK - jnp.arange(2 * BAND_BLK)[None, :]
    key_n = (jnp.arange(nb)[:, None] - 1) * BAND_BLK + jnp.arange(2 * BAND_BLK)[None, :]
    valid = ((rel >= 0) & (rel <= LOOKBACK))[None] & (key_n >= 0)[:, None, :]
    alibi = -slopes[:, None, None] * (dilation * rel).astype(jnp.float32)[None]
    s = jnp.where(valid[None, None, :, None], s * (E ** -0.5) + alibi[None, None, None], NEG_INF)
    m = jnp.max(s, axis=-1, keepdims=True)
    p = jnp.exp(s - m)
    den = jnp.sum(p, axis=-1)
    o = jnp.einsum('brnhqk,brnkhe->brnqhe', p.astype(v.dtype), vb, preferred_element_type=jnp.float32)
    o = o / jnp.moveaxis(den, 3, 4)[..., None]
    lse = jnp.moveaxis(m[..., 0] + jnp.log(den), 3, 4)

    def unstrided(a):
        a = a.reshape((B, dilation, Lp) + a.shape[4:])[:, :, :L]
        return jnp.swapaxes(a, 1, 2).reshape((B, S) + a.shape[3:])

    return unstrided(o), unstrided(lse)


def mla_layer(h, ln, w_in, ln_q, w_q_up, ln_kv, w_kv_up, g_q, g_k, w_o):
    B, S, _ = h.shape
    u = rms_norm(h, ln) @ w_in
    c_q = u[..., :Q_LORA]
    c_kv = u[..., Q_LORA:Q_LORA + KV_LORA]
    k_pe = u[..., Q_LORA + KV_LORA:Q_LORA + KV_LORA + QK_ROPE]
    gate = u[..., Q_LORA + KV_LORA + QK_ROPE:]
    q = (rms_norm(c_q, ln_q) @ w_q_up).reshape(B, S, MLA_HEADS, QK_HEAD)
    kv = (rms_norm(c_kv, ln_kv) @ w_kv_up).reshape(B, S, MLA_HEADS, QK_NOPE + V_HEAD)
    v = kv[..., QK_NOPE:]
    k = jnp.concatenate([kv[..., :QK_NOPE],
                         jnp.broadcast_to(k_pe[:, :, None, :], (B, S, MLA_HEADS, QK_ROPE))], axis=-1)
    q = rms_norm(q, g_q)
    k = rms_norm(k, g_k)
    pos = jnp.arange(S)
    q = jnp.concatenate([q[..., :QK_NOPE], rope(q[..., QK_NOPE:], pos)], axis=-1)
    k = jnp.concatenate([k[..., :QK_NOPE], rope(k[..., QK_NOPE:], pos)], axis=-1)
    o = causal_dense_attention(q, k, v).reshape(B, S, MLA_WIDTH)
    return h + (o * jax.nn.silu(gate)) @ w_o


def shared_kv(h, ln, w_kv, g_k):
    B, S, _ = h.shape
    u = (rms_norm(h, ln) @ w_kv).reshape(B, S, 2, N_GROUPS, DIL_HEADS, DIL_HEAD_DIM)
    k = rms_norm(u[:, :, 0], g_k[:, None, :])
    v = u[:, :, 1]
    return k, v


def dilated_layer(h, k_sh, v_sh, ln, w_in, g_q, w_o):
    B, S, _ = h.shape
    u = rms_norm(h, ln) @ w_in
    q_all = u[..., :B_Q_COLS].reshape(B, S, N_GROUPS, DIL_HEADS, DIL_HEAD_DIM)
    gate = u[..., B_Q_COLS:]
    slopes = 2.0 ** (-ALIBI_MAX * jnp.arange(1, DIL_HEADS + 1, dtype=jnp.float32) / DIL_HEADS)
    outs, lses = [], []
    for g, (_, dil) in enumerate(DIL_GROUPS):
        q = rms_norm(q_all[:, :, g], g_q[g])
        o_g, lse_g = dilated_group_attention(q, k_sh[:, :, g], v_sh[:, :, g], dil, slopes)
        outs.append(o_g)
        lses.append(lse_g)
    wts = jax.nn.softmax(jnp.stack(lses, axis=-1), axis=-1)
    o = jnp.einsum('bshge,bshg->bshe', jnp.stack(outs, axis=3), wts)
    o = o.astype(h.dtype).reshape(B, S, DIL_WIDTH)
    return h + (o * jax.nn.silu(gate)) @ w_o


def setup_inputs(seed: int = 0) -> dict:
    key = jax.random.key(seed)
    ks = jax.random.split(key, 20)
    f32 = jnp.float32

    def w(k, shape, fan_in):
        return jax.random.normal(k, shape, f32) * (fan_in ** -0.5)

    def gain(k, shape):
        return 1.0 + 0.02 * jax.random.normal(k, shape, f32)

    nA, nB = N_A_LAYERS, N_B_LAYERS
    return {
        "x": jax.random.normal(ks[0], (BATCH, SEQ, D_MODEL), f32),
        "a_ln": gain(ks[1], (nA, D_MODEL)),
        "a_w_in": w(ks[2], (nA, D_MODEL, A_IN_COLS), D_MODEL),
        "a_ln_q": gain(ks[3], (nA, Q_LORA)),
        "a_w_q_up": w(ks[4], (nA, Q_LORA, MLA_HEADS * QK_HEAD), Q_LORA),
        "a_ln_kv": gain(ks[5], (nA, KV_LORA)),
        "a_w_kv_up": w(ks[6], (nA, KV_LORA, MLA_HEADS * (QK_NOPE + V_HEAD)), KV_LORA),
        "a_q_norm": gain(ks[7], (nA, QK_HEAD)),
        "a_k_norm": gain(ks[8], (nA, QK_HEAD)),
        "a_w_o": w(ks[9], (nA, MLA_WIDTH, D_MODEL), MLA_WIDTH),
        "kv_ln": gain(ks[10], (D_MODEL,)),
        "kv_w": w(ks[11], (D_MODEL, KV_SHARED_COLS), D_MODEL),
        "kv_k_norm": gain(ks[12], (N_GROUPS, DIL_HEAD_DIM)),
        "b_ln": gain(ks[13], (nB, D_MODEL)),
        "b_w_in": w(ks[14], (nB, D_MODEL, B_IN_COLS), D_MODEL),
        "b_q_norm": gain(ks[15], (nB, N_GROUPS, DIL_HEAD_DIM)),
        "b_w_o": w(ks[16], (nB, DIL_WIDTH, D_MODEL), DIL_WIDTH),
    }


def reference(x, a_ln, a_w_in, a_ln_q, a_w_q_up, a_ln_kv, a_w_kv_up, a_q_norm, a_k_norm, a_w_o,
              kv_ln, kv_w, kv_k_norm, b_ln, b_w_in, b_q_norm, b_w_o):
    h = x
    k_sh, v_sh = None, None
    for layer in range(DEPTH):
        if layer < N_A_LAYERS:
            i = layer
            h = mla_layer(h, a_ln[i], a_w_in[i], a_ln_q[i], a_w_q_up[i], a_ln_kv[i], a_w_kv_up[i],
                          a_q_norm[i], a_k_norm[i], a_w_o[i])
        else:
            if layer == N_A_LAYERS:
                k_sh, v_sh = shared_kv(h, kv_ln, kv_w, kv_k_norm)
            j = layer - N_A_LAYERS
            h = dilated_layer(h, k_sh, v_sh, b_ln[j], b_w_in[j], b_q_norm[j], b_w_o[j])
    return h
```

```cpp
#include <hip/hip_runtime.h>
#include <hip/hip_cooperative_groups.h>
#include <cstdio>
#include <cstdint>
namespace cg = cooperative_groups;
__device__ __forceinline__ int lane_id() { return (int)__builtin_amdgcn_mbcnt_hi(~0u, __builtin_amdgcn_mbcnt_lo(~0u, 0u)); }
namespace pg8 {
#define PG8_LAS __attribute__((address_space(3)))
typedef unsigned short bf16_t;
typedef short bf16x8 __attribute__((ext_vector_type(8)));
typedef float f32x4 __attribute__((ext_vector_type(4)));
typedef unsigned u32x4 __attribute__((ext_vector_type(4)));
constexpr int BM = 256, BK = 64, HALF = 128, HTB = HALF * BK * 2  , STAGE_BYTES = 8 * HTB, NXCD = 8, WGM = 4;

__host__ __device__ __forceinline__ int lds_byte(int r, int c) { const int st = (r >> 4) * 2 + (c >> 5), rr = r & 15, cc = c & 31, ob = rr * 64 + cc * 2; return st * 1024 + (ob ^ (((ob >> 9) & 1) << 5)); }
__host__ __device__ __forceinline__ void stage_rc(int b, int& R, int& C) { const int st = b / 1024, sb = b % 1024, swz = sb ^ (((sb >> 9) & 1) << 5); R = (st >> 1) * 16 + swz / 64; C = (st & 1) * 32 + (swz % 64) / 2; }
__host__ __device__ __forceinline__ int perm32(int rho) { const int n = rho >> 4, i = rho & 15; return 8 * (i >> 2) + 4 * n + (i & 3); }

struct Unit { int pm, pn; };
struct Gemm { const bf16_t* A; const bf16_t* Bt; int M, N, K, lda; };

struct StaticOrder {
    int nM, nN, nwg, G, c;
    __host__ __device__ void init(int M, int N, int G_, int c_) { nM = M / BM; nN = N / BM; nwg = nM * nN; G = G_; c = c_; }
    __host__ __device__ bool next(int i, Unit& u) const {
        const long L = (long)i * G + c; if (L >= nwg) return false;
        int wgid = (int)L; { const int q = nwg / NXCD, r = nwg % NXCD, xcd = wgid % NXCD, off = wgid / NXCD; wgid = (xcd < r ? xcd * (q + 1) : r * (q + 1) + (xcd - r) * q) + off; }
        const int nig = WGM * nN, gid = wgid / nig, fm = gid * WGM, gsz = (nM - fm) < WGM ? (nM - fm) : WGM;
        u.pm = fm + ((wgid % nig) % gsz); u.pn = (wgid % nig) / gsz; return true;
    }
    __device__ __forceinline__ void a_ready(const Unit&) const {}
    __device__ __forceinline__ void done(const Unit&) const {}
};

__device__ __forceinline__ unsigned cvt_pk_bf16(float lo, float hi) { unsigned r; asm volatile("v_cvt_pk_bf16_f32 %0, %1, %2" : "=v"(r) : "v"(lo), "v"(hi)); return r; }
template <class Epi, class Sched, bool ALIGN_EPI, bool SP2, int KC, int LDAC>
__device__ __forceinline__ void gemm_phase(PG8_LAS unsigned char* lds, const Gemm g, const Sched& S, const Epi& E, int wid_in) {
    const int wid = __builtin_amdgcn_readfirstlane(wid_in), lane = lane_id(), tid = wid * 64 + lane, wr = wid >> 2, wc = wid & 3, fr = lane & 15, fq = lane >> 4;
    constexpr int K = KC, nt = K / BK, lda = LDAC;
    unsigned voffA[2], voffB[2];
#pragma unroll
    for (int i = 0; i < 2; ++i) { int R, C; stage_rc(tid * 16 + i * 8192, R, C); const int Rb = Epi::PERM ? ((R & ~31) + perm32(R & 31)) : R;
        voffA[i] = (unsigned)(R * lda + C) * 2u; voffB[i] = (unsigned)(Rb * K + C) * 2u; }
    const size_t kstep = (size_t)(BK * 2);
    const size_t hstep = (size_t)HALF * K * 2;
    const size_t tstep = 2 * hstep; const size_t hstepA = (size_t)HALF * lda * 2, tstepA = 2 * hstepA;
    const unsigned ldsw = (unsigned)wid * 1024u;
    const int aoff = lds_byte(wr * 64 + fr, fq * 8), boff = lds_byte(wc * 32 + fr, fq * 8);
#define PG8_SA(b, h) (((b) * 2 + (h)) * HTB)
#define PG8_SB(b, h) ((4 + (b) * 2 + (h)) * HTB)
#define PG8_STAGE(bufoff, gbase, voff) do { _Pragma("unroll") for (int _i = 0; _i < 2; ++_i) \
        __builtin_amdgcn_global_load_lds((const unsigned*)((const char*)(gbase) + (voff)[_i]), (PG8_LAS unsigned*)(lds + (bufoff) + ldsw + _i * 8192), 16, 0, 0); } while (0)
#define PG8_LDA(dst, b, h) do { _Pragma("unroll") for (int m = 0; m < 4; ++m) _Pragma("unroll") for (int k = 0; k < 2; ++k) dst[m][k] = *(const PG8_LAS bf16x8*)(lds + PG8_SA(b, h) + aoff + m * 2048 + k * 1024); } while (0)
#define PG8_LDB(dst, b, h) do { _Pragma("unroll") for (int n = 0; n < 2; ++n) _Pragma("unroll") for (int k = 0; k < 2; ++k) dst[n][k] = *(const PG8_LAS bf16x8*)(lds + PG8_SB(b, h) + boff + n * 2048 + k * 1024); } while (0)
#define PG8_MMA(ai, bj, At, Bt) do { __builtin_amdgcn_s_setprio(1); _Pragma("unroll") for (int m = 0; m < 4; ++m) _Pragma("unroll") for (int n = 0; n < 2; ++n) _Pragma("unroll") for (int k = 0; k < 2; ++k) \
        acc[ai][bj][m][n] = __builtin_amdgcn_mfma_f32_16x16x32_bf16(Bt[n][k], At[m][k], acc[ai][bj][m][n], 0, 0, 0); __builtin_amdgcn_s_setprio(0); } while (0)
#define PG8_WAIT_V(n) asm volatile("s_waitcnt vmcnt(" #n ")" ::: "memory")
#define PG8_WAIT_L(n) asm volatile("s_waitcnt lgkmcnt(" #n ")" ::: "memory")
#define PG8_BAR __builtin_amdgcn_s_barrier()
#define PG8_SCHED __builtin_amdgcn_sched_barrier(0)
    Unit cur, nxt; int ui = 0;
    if (!S.next(0, cur)) return;
    f32x4 acc[2][2][4][2];
#pragma unroll
    for (int a = 0; a < 2; ++a)
#pragma unroll
        for (int b = 0; b < 2; ++b)
#pragma unroll
            for (int m = 0; m < 4; ++m)
#pragma unroll
                for (int n = 0; n < 2; ++n) acc[a][b][m][n] = (f32x4){0.f, 0.f, 0.f, 0.f};
    bf16x8 At[4][2], B0[2][2], B1[2][2];
    const char* cA = (const char*)g.A + (size_t)cur.pm * tstepA; const char* cB = (const char*)g.Bt + (size_t)cur.pn * tstep;
    S.a_ready(cur);
    if constexpr (SP2) {
        PG8_STAGE(PG8_SB(0, 0), cB, voffB); PG8_STAGE(PG8_SB(0, 1), cB + hstep, voffB); PG8_STAGE(PG8_SA(0, 0), cA, voffA); PG8_STAGE(PG8_SA(0, 1), cA + hstepA, voffA);
        if (wr == 1) PG8_BAR;
        PG8_WAIT_V(2); PG8_BAR;
        PG8_STAGE(PG8_SB(1, 0), cB + kstep, voffB); PG8_STAGE(PG8_SA(1, 0), cA + kstep, voffA); PG8_STAGE(PG8_SB(1, 1), cB + hstep + kstep, voffB);
        PG8_WAIT_V(6); PG8_BAR;
    } else {
        PG8_STAGE(PG8_SB(0, 0), cB, voffB); PG8_STAGE(PG8_SA(0, 0), cA, voffA); PG8_STAGE(PG8_SB(0, 1), cB + hstep, voffB); PG8_STAGE(PG8_SA(0, 1), cA + hstepA, voffA);
        if (wr == 1) PG8_BAR;
        PG8_WAIT_V(4); PG8_BAR;
        PG8_STAGE(PG8_SB(1, 0), cB + kstep, voffB); PG8_STAGE(PG8_SA(1, 0), cA + kstep, voffA); PG8_STAGE(PG8_SB(1, 1), cB + hstep + kstep, voffB);
        PG8_WAIT_V(6); PG8_BAR;
    }
    for (;;) {
        const bool has_next = S.next(ui + 1, nxt);
        const char* nA = has_next ? (const char*)g.A + (size_t)nxt.pm * tstepA : cA; const char* nB = has_next ? (const char*)g.Bt + (size_t)nxt.pn * tstep : cB;
        for (int t = 0; t < nt; t += 2) {
            const bool last = (t == nt - 2);
            const char* a1 = cA + (size_t)(t + 1) * kstep;
            const char* a2 = last ? nA : cA + (size_t)(t + 2) * kstep; const char* b2 = last ? nB : cB + (size_t)(t + 2) * kstep;
            const char* a3 = a2 + kstep; const char* b3 = b2 + kstep;
            if (last && has_next) S.a_ready(nxt);
            if constexpr (SP2) {
            PG8_LDB(B0, 0, 0); PG8_LDB(B1, 0, 1); PG8_SCHED; PG8_LDA(At, 0, 0); PG8_STAGE(PG8_SA(1, 1), a1 + hstepA, voffA);
            PG8_WAIT_V(8); PG8_WAIT_L(0); PG8_BAR; PG8_MMA(0, 0, At, B0); PG8_MMA(0, 1, At, B1); PG8_BAR; PG8_SCHED;
            PG8_LDA(At, 0, 1); PG8_STAGE(PG8_SB(0, 0), b2, voffB); PG8_STAGE(PG8_SB(0, 1), b2 + hstep, voffB); PG8_STAGE(PG8_SA(0, 0), a2, voffA);
            PG8_WAIT_V(8); PG8_WAIT_L(0); PG8_BAR; PG8_MMA(1, 0, At, B0); PG8_MMA(1, 1, At, B1); PG8_BAR; PG8_SCHED;
            PG8_LDB(B0, 1, 0); PG8_LDB(B1, 1, 1); PG8_SCHED; PG8_LDA(At, 1, 0); PG8_STAGE(PG8_SA(0, 1), a2 + hstepA, voffA);
            PG8_WAIT_V(8); PG8_WAIT_L(0); PG8_BAR; PG8_MMA(0, 0, At, B0); PG8_MMA(0, 1, At, B1); PG8_BAR; PG8_SCHED;
            PG8_LDA(At, 1, 1); PG8_STAGE(PG8_SB(1, 0), b3, voffB); PG8_STAGE(PG8_SB(1, 1), b3 + hstep, voffB); PG8_STAGE(PG8_SA(1, 0), a3, voffA);
            PG8_WAIT_V(8); PG8_WAIT_L(0); PG8_BAR; PG8_MMA(1, 0, At, B0); PG8_MMA(1, 1, At, B1); PG8_BAR; PG8_SCHED;
            } else {
            PG8_LDB(B0, 0, 0); PG8_SCHED; PG8_LDA(At, 0, 0); PG8_STAGE(PG8_SA(1, 1), a1 + hstepA, voffA);
            PG8_WAIT_L(8); PG8_BAR; PG8_WAIT_L(0); PG8_MMA(0, 0, At, B0); PG8_BAR; PG8_SCHED;
            PG8_LDB(B1, 0, 1); PG8_STAGE(PG8_SB(0, 0), b2, voffB);
            PG8_BAR; PG8_WAIT_L(0); PG8_MMA(0, 1, At, B1); PG8_BAR;
            PG8_LDA(At, 0, 1); PG8_STAGE(PG8_SA(0, 0), a2, voffA);
            PG8_BAR; PG8_WAIT_L(0); PG8_MMA(1, 0, At, B0); PG8_BAR; PG8_SCHED;
            PG8_STAGE(PG8_SB(0, 1), b2 + hstep, voffB);
            PG8_WAIT_V(6); PG8_BAR; PG8_MMA(1, 1, At, B1); PG8_BAR;
            PG8_LDB(B0, 1, 0); PG8_SCHED; PG8_LDA(At, 1, 0); PG8_STAGE(PG8_SA(0, 1), a2 + hstepA, voffA);
            PG8_WAIT_L(8); PG8_BAR; PG8_WAIT_L(0); PG8_MMA(0, 0, At, B0); PG8_BAR; PG8_SCHED;
            PG8_LDB(B1, 1, 1); PG8_STAGE(PG8_SB(1, 0), b3, voffB);
            PG8_BAR; PG8_WAIT_L(0); PG8_MMA(0, 1, At, B1); PG8_BAR;
            PG8_LDA(At, 1, 1); PG8_STAGE(PG8_SA(1, 0), a3, voffA);
            PG8_BAR; PG8_WAIT_L(0); PG8_MMA(1, 0, At, B0); PG8_BAR; PG8_SCHED;
            PG8_STAGE(PG8_SB(1, 1), b3 + hstep, voffB);
            PG8_WAIT_V(6); PG8_BAR; PG8_MMA(1, 1, At, B1); PG8_BAR;
            }
        }
        if constexpr (ALIGN_EPI) { if (wr == 0) PG8_BAR; }
        if constexpr (!Epi::AFTER_DRAIN) { E(acc, cur, wr, wc, fr, fq); S.done(cur); }
        if (!has_next) break;
#pragma unroll
        for (int a = 0; a < 2; ++a)
#pragma unroll
            for (int b = 0; b < 2; ++b)
#pragma unroll
                for (int m = 0; m < 4; ++m)
#pragma unroll
                    for (int n = 0; n < 2; ++n) acc[a][b][m][n] = (f32x4){0.f, 0.f, 0.f, 0.f};
        cur = nxt; cA = nA; cB = nB; ++ui;
        if constexpr (ALIGN_EPI) { if (wr == 1) PG8_BAR; }
    }
    PG8_WAIT_V(0);
    if constexpr (!ALIGN_EPI) { if (wr == 0) PG8_BAR; }
    PG8_BAR;
    if constexpr (Epi::AFTER_DRAIN) { E.fused(acc, cur, wr, wc, fr, fq, lds, wid, lane); S.done(cur); }
#undef PG8_SA
#undef PG8_SB
#undef PG8_STAGE
#undef PG8_LDA
#undef PG8_LDB
#undef PG8_MMA
#undef PG8_WAIT_V
#undef PG8_WAIT_L
#undef PG8_BAR
#undef PG8_SCHED
}
}

namespace pg8 {
struct EpiSt {
    static constexpr bool PERM = true, AFTER_DRAIN = false;
    bf16_t* O; int ldc; int ncut; bf16_t* O2; int ldc2; int col2;
    __device__ __forceinline__ void operator()(const f32x4 (&acc)[2][2][4][2], const Unit& u, int wr, int wc, int fr, int fq) const {
        const int row0 = u.pm * BM + wr * 64 + fr;
        bf16_t* base = O; int ld = ldc; int colt = u.pn * BM;
        if (u.pn >= ncut) { base = O2; ld = ldc2; colt = col2 + (u.pn - ncut) * BM; }
        const int col0 = colt + wc * 32 + 8 * fq;
#pragma unroll
        for (int ai = 0; ai < 2; ++ai)
#pragma unroll
            for (int m = 0; m < 4; ++m) { bf16_t* rowp = base + (size_t)(row0 + ai * HALF + m * 16) * ld + col0;
#pragma unroll
                for (int bj = 0; bj < 2; ++bj) { const f32x4 v0 = acc[ai][bj][m][0], v1 = acc[ai][bj][m][1];
                    u32x4 w; w.x = cvt_pk_bf16(v0[0], v0[1]); w.y = cvt_pk_bf16(v0[2], v0[3]); w.z = cvt_pk_bf16(v1[0], v1[1]); w.w = cvt_pk_bf16(v1[2], v1[3]);
                    *(u32x4*)(rowp + bj * HALF) = w; } }
    }
};
struct EpiStNorm {
    static constexpr bool PERM = true, AFTER_DRAIN = false;
    bf16_t* O; int ldc; int ncut; bf16_t* O2; int ldc2; int col2; const float* gq; const float* gk; PG8_LAS float* P; float qscale, eps;
    __device__ __forceinline__ void operator()(const f32x4 (&acc)[2][2][4][2], const Unit& u, int wr, int wc, int fr, int fq) const {
        const int row0 = u.pm * BM + wr * 64 + fr;
        const bool gate = u.pn >= ncut;
        bf16_t* base = O; int ld = ldc; int colt = u.pn * BM;
        if (gate) { base = O2; ld = ldc2; colt = col2 + (u.pn - ncut) * BM; }
        const int col0 = colt + wc * 32 + 8 * fq;
        int part[2], br[2];
#pragma unroll
        for (int bj = 0; bj < 2; ++bj) { const int rem = (u.pn * 2 + bj) % 9; part[bj] = gate ? 2 : rem / 3; br[bj] = rem % 3; }
        f32x4 cg[2][2];
#pragma unroll
        for (int bj = 0; bj < 2; ++bj) {
            cg[bj][0] = (f32x4){1.f, 1.f, 1.f, 1.f}; cg[bj][1] = cg[bj][0];
            if (part[bj] == 0) { const int e = br[bj] * 128 + wc * 32 + 8 * fq;
                cg[bj][0] = *(const f32x4*)(gq + e) * *(const f32x4*)(gk + e) * qscale; cg[bj][1] = *(const f32x4*)(gq + e + 4) * *(const f32x4*)(gk + e + 4) * qscale; } }
        float sc[2][2][4];
#pragma unroll
        for (int ai = 0; ai < 2; ++ai)
#pragma unroll
            for (int bj = 0; bj < 2; ++bj)
#pragma unroll
                for (int m = 0; m < 4; ++m) sc[ai][bj][m] = 1.f;
        if (part[0] < 2 || part[1] < 2) {
#pragma unroll
            for (int ai = 0; ai < 2; ++ai)
#pragma unroll
                for (int bj = 0; bj < 2; ++bj)
#pragma unroll
                    for (int m = 0; m < 4; ++m) if (part[bj] < 2) { const f32x4 a = acc[ai][bj][m][0], b = acc[ai][bj][m][1];
                        float q = (a[0] * a[0] + a[1] * a[1]) + (a[2] * a[2] + a[3] * a[3]) + (b[0] * b[0] + b[1] * b[1]) + (b[2] * b[2] + b[3] * b[3]);
                        { auto rr = __builtin_amdgcn_permlane16_swap(__float_as_uint(q), __float_as_uint(q), false, false); q = __uint_as_float(rr[0]) + __uint_as_float(rr[1]); }
                        { auto rr = __builtin_amdgcn_permlane32_swap(__float_as_uint(q), __float_as_uint(q), false, false); q = __uint_as_float(rr[0]) + __uint_as_float(rr[1]); }
                        if (fq == 0) P[(bj * 256 + ai * HALF + wr * 64 + m * 16 + fr) * 4 + wc] = q; }
            asm volatile("s_waitcnt lgkmcnt(0)\n\ts_barrier" ::: "memory");
#pragma unroll
            for (int ai = 0; ai < 2; ++ai)
#pragma unroll
                for (int bj = 0; bj < 2; ++bj)
#pragma unroll
                    for (int m = 0; m < 4; ++m) if (part[bj] < 2) { const f32x4 t = *(const PG8_LAS f32x4*)(P + (bj * 256 + ai * HALF + wr * 64 + m * 16 + fr) * 4);
                        sc[ai][bj][m] = __builtin_amdgcn_rsqf(((t[0] + t[1]) + (t[2] + t[3])) * (1.0f / 128.0f) + eps); }
        }
#pragma unroll
        for (int ai = 0; ai < 2; ++ai)
#pragma unroll
            for (int m = 0; m < 4; ++m) { bf16_t* rowp = base + (size_t)(row0 + ai * HALF + m * 16) * ld + col0;
#pragma unroll
                for (int bj = 0; bj < 2; ++bj) { const f32x4 v0 = acc[ai][bj][m][0] * cg[bj][0] * sc[ai][bj][m], v1 = acc[ai][bj][m][1] * cg[bj][1] * sc[ai][bj][m];
                    u32x4 w; w.x = cvt_pk_bf16(v0[0], v0[1]); w.y = cvt_pk_bf16(v0[2], v0[3]); w.z = cvt_pk_bf16(v1[0], v1[1]); w.w = cvt_pk_bf16(v1[2], v1[3]);
                    *(u32x4*)(rowp + bj * HALF) = w; } }
    }
};
struct EpiRes {
    static constexpr bool PERM = false, AFTER_DRAIN = false;
    const float* base; float* out; int ldc; bool nt_ld, nt_st;
    __device__ __forceinline__ void operator()(const f32x4 (&acc)[2][2][4][2], const Unit& u, int wr, int wc, int fr, int fq) const {
        const int col0 = u.pn * BM + wc * 32 + 4 * fq;
#pragma unroll
        for (int ai = 0; ai < 2; ++ai) {
            const size_t off0 = (size_t)(u.pm * BM + ai * HALF + wr * 64 + fr) * ldc + col0;
            f32x4 bs[4][2][2];
#pragma unroll
            for (int m = 0; m < 4; ++m)
#pragma unroll
                for (int bj = 0; bj < 2; ++bj)
#pragma unroll
                    for (int n = 0; n < 2; ++n) { const f32x4* p_ = (const f32x4*)(base + off0 + (size_t)m * 16 * ldc + bj * HALF + n * 16); bs[m][bj][n] = nt_ld ? __builtin_nontemporal_load(p_) : *p_; }
            asm volatile("" ::: "memory");
#pragma unroll
            for (int m = 0; m < 4; ++m)
#pragma unroll
                for (int bj = 0; bj < 2; ++bj)
#pragma unroll
                    for (int n = 0; n < 2; ++n) { f32x4* q_ = (f32x4*)(out + off0 + (size_t)m * 16 * ldc + bj * HALF + n * 16); const f32x4 r_ = bs[m][bj][n] + acc[ai][bj][m][n]; if (nt_st) __builtin_nontemporal_store(r_, q_); else *q_ = r_; }
            asm volatile("" ::: "memory");
        }
    }
};
}

constexpr int SEQ = 16384, NTOK = 32768, DM = 2048;
constexpr int UCOLS = 3328;
constexpr int QCOLS = 3072, KVCOLS = 4096, KRCOLS = 1024;
constexpr int GCOLS = 4608, GN = 5120;
constexpr float EPSN = 1e-6f;
constexpr float LOG2E = 1.4426950408889634f;
constexpr float QSCALE_A = 0.10411754627697264f;
constexpr float QSCALE_B = 0.12751743082459868f;
constexpr size_t MiB = 1u << 20;
constexpr size_t WS_WAIN = 0, WS_WQUP = 14 * MiB, WS_WKVUP = 17 * MiB, WS_WAO = 21 * MiB, WS_WBALL = 29 * MiB, WS_WBO = 109 * MiB;
constexpr size_t WS_LSE = 120 * MiB, WS_ROPE = 122 * MiB;
constexpr size_t WS_XN = 144 * MiB;
constexpr size_t WS_U = 272 * MiB, WS_Q = 480 * MiB, WS_KV = 672 * MiB, WS_KR = 928 * MiB;
constexpr size_t WS_G = 272 * MiB, WS_GATE = 560 * MiB, WS_OP = 688 * MiB, WS_OG = 784 * MiB;
constexpr size_t WS_END = 992 * MiB;
constexpr int LDS_BYTES = 147456;
constexpr int NPHASE = 20;
constexpr int DUP = 0;

typedef unsigned short bf16;
typedef short bf16x8 __attribute__((ext_vector_type(8)));
typedef short s16x4 __attribute__((ext_vector_type(4)));
typedef float f32x16 __attribute__((ext_vector_type(16)));
typedef float f32x4 __attribute__((ext_vector_type(4)));
typedef unsigned u32x4 __attribute__((ext_vector_type(4)));
typedef unsigned u32x2 __attribute__((ext_vector_type(2)));
#define LAS __attribute__((address_space(3)))

struct Args { const float* in[17]; float* out; unsigned char* ws; int ph_lo, ph_hi; };

__device__ __forceinline__ float bf2f(unsigned short h) { return __uint_as_float((unsigned)h << 16); }
__device__ __forceinline__ float bflo(unsigned w) { return __uint_as_float(w << 16); }
__device__ __forceinline__ float bfhi(unsigned w) { return __uint_as_float(w & 0xffff0000u); }
__device__ __forceinline__ unsigned cvtpk(float lo, float hi) { unsigned r; asm volatile("v_cvt_pk_bf16_f32 %0, %1, %2" : "=v"(r) : "v"(lo), "v"(hi)); return r; }
__device__ __forceinline__ unsigned short f2bf(float f) { return (unsigned short)(cvtpk(f, 0.f) & 0xffffu); }
__device__ __forceinline__ float wave_sum(float v) {
#pragma unroll
    for (int o = 1; o < 64; o <<= 1) v += __shfl_xor(v, o);
    return v;
}
__device__ __forceinline__ float silu_f(float g) { return g * __builtin_amdgcn_rcpf(1.f + __builtin_amdgcn_exp2f(g * -1.4426950408889634f)); }

__device__ __forceinline__ int dst_row(int map, int n0) {
    if (map == 0) return n0;
    if (map == 1) { const int part2 = n0 / 6144, r = n0 % 6144, br = r / 2048, h = (r % 2048) / 128, e = r % 128;
        return (h >> 2) * GN + (h & 3) * 1152 + (1 + part2) * 384 + br * 128 + e; }
    if (n0 < 6144) { const int br = n0 / 2048, h = (n0 % 2048) / 128, e = n0 % 128; return (h >> 2) * GN + (h & 3) * 1152 + br * 128 + e; }
    { const int c = n0 - 6144, h = c / 128, e = c % 128; return (h >> 2) * GN + GCOLS + (h & 3) * 128 + e; }
}
__device__ __forceinline__ void transpose_item(const float* W, int K, int N, const float* gain, bf16* WT, int map, LAS float* scr, int item, int lane) {
    const int nblk = N / 32, kb = item / nblk, nb = item % nblk, k0 = 64 * kb, n0 = 32 * nb;
    float wv[32];
#pragma unroll
    for (int i = 0; i < 32; ++i) wv[i] = __builtin_nontemporal_load(W + (size_t)(k0 + 2 * i + (lane >> 5)) * N + n0 + (lane & 31));
#pragma unroll
    for (int i = 0; i < 32; ++i) { const int kk = 2 * i + (lane >> 5); const float gsc = gain ? gain[k0 + kk] : 1.f;
        scr[kk * 33 + (lane & 31)] = wv[i] * gsc; }
    asm volatile("s_waitcnt lgkmcnt(0)" ::: "memory");
    const int c = lane & 7; const int d0 = dst_row(map, n0);
#pragma unroll
    for (int j = 0; j < 4; ++j) { const int n = (lane >> 3) + 8 * j; const LAS float* s = scr + (8 * c) * 33 + n;
        u32x4 o; o.x = cvtpk(s[0 * 33], s[1 * 33]); o.y = cvtpk(s[2 * 33], s[3 * 33]); o.z = cvtpk(s[4 * 33], s[5 * 33]); o.w = cvtpk(s[6 * 33], s[7 * 33]);
        *(u32x4*)(WT + (size_t)(d0 + n) * K + k0 + 8 * c) = o; }
    asm volatile("s_waitcnt lgkmcnt(0)" ::: "memory");
}
__device__ __forceinline__ void norm_row(const float* xrow, bf16* orow, int lane) {
    const f32x4* xr = (const f32x4*)xrow + lane;
    f32x4 v[8]; float s = 0.f;
#pragma unroll
    for (int j = 0; j < 8; ++j) { v[j] = xr[64 * j]; s += (v[j].x * v[j].x + v[j].y * v[j].y) + (v[j].z * v[j].z + v[j].w * v[j].w); }
    const float rstd = __builtin_amdgcn_rsqf(wave_sum(s) * (1.f / DM) + EPSN);
    u32x2* o8 = (u32x2*)orow + lane;
#pragma unroll
    for (int j = 0; j < 8; ++j) { u32x2 w; w.x = cvtpk(v[j].x * rstd, v[j].y * rstd); w.y = cvtpk(v[j].z * rstd, v[j].w * rstd); o8[64 * j] = w; }
}

template <bool NT_> __device__ __forceinline__ void norm_row2(const float* xa, bf16* oa, const float* xb, bf16* ob, int lane) {
    const f32x4* ra = (const f32x4*)xa + lane; const f32x4* rb = (const f32x4*)xb + lane;
    f32x4 va[8], vb[8]; float sa = 0.f, sb = 0.f;
#pragma unroll
    for (int j = 0; j < 8; ++j) { if (NT_) { va[j] = __builtin_nontemporal_load(ra + 64 * j); vb[j] = __builtin_nontemporal_load(rb + 64 * j); } else { va[j] = ra[64 * j]; vb[j] = rb[64 * j]; } }
#pragma unroll
    for (int j = 0; j < 8; ++j) { sa += (va[j].x * va[j].x + va[j].y * va[j].y) + (va[j].z * va[j].z + va[j].w * va[j].w);
                                  sb += (vb[j].x * vb[j].x + vb[j].y * vb[j].y) + (vb[j].z * vb[j].z + vb[j].w * vb[j].w); }
    const float rsa = __builtin_amdgcn_rsqf(wave_sum(sa) * (1.f / DM) + EPSN), rsb = __builtin_amdgcn_rsqf(wave_sum(sb) * (1.f / DM) + EPSN);
    u32x2* pa = (u32x2*)oa + lane; u32x2* pb = (u32x2*)ob + lane;
#pragma unroll
    for (int j = 0; j < 8; ++j) { u32x2 w; w.x = cvtpk(va[j].x * rsa, va[j].y * rsa); w.y = cvtpk(va[j].z * rsa, va[j].w * rsa); pa[64 * j] = w;
                                  u32x2 z; z.x = cvtpk(vb[j].x * rsb, vb[j].y * rsb); z.y = cvtpk(vb[j].z * rsb, vb[j].w * rsb); pb[64 * j] = z; }
}

__device__ __forceinline__ void sincos_pos(int s, int i, float& c, float& sn) {
    double inv = 1.0;
    if (i & 1) inv *= 0.7498942093324559; if (i & 2) inv *= 0.5623413251903491; if (i & 4) inv *= 0.31622776601683794; if (i & 8) inv *= 0.1; if (i & 16) inv *= 0.01;
    const double a = (double)s * inv;
    const double k = __builtin_rint(a * 0.15915494309189535);
    double r = __builtin_fma(-k, 6.283185307179586, a); r = __builtin_fma(-k, 2.4492935982947064e-16, r);
    const double r2 = r * r;
    double ps = -3.868170170630684e-23; ps = ps * r2 + 1.9572941063391263e-20; ps = ps * r2 - 8.22063524662433e-18; ps = ps * r2 + 2.8114572543455206e-15; ps = ps * r2 - 7.647163731819816e-13;
    ps = ps * r2 + 1.6059043836821613e-10; ps = ps * r2 - 2.505210838544172e-08; ps = ps * r2 + 2.7557319223985893e-06; ps = ps * r2 - 0.0001984126984126984; ps = ps * r2 + 0.008333333333333333;
    ps = ps * r2 - 0.16666666666666666; ps = ps * r2 + 1.0;
    double pc = -8.896791392450574e-22; pc = pc * r2 + 4.110317623312165e-19; pc = pc * r2 - 1.5619206968586225e-16; pc = pc * r2 + 4.779477332387385e-14; pc = pc * r2 - 1.1470745597729725e-11;
    pc = pc * r2 + 2.08767569878681e-09; pc = pc * r2 - 2.755731922398589e-07; pc = pc * r2 + 2.48015873015873e-05; pc = pc * r2 - 0.001388888888888889; pc = pc * r2 + 0.041666666666666664;
    pc = pc * r2 - 0.5; pc = pc * r2 + 1.0;
    sn = (float)(ps * r); c = (float)pc;
}
__device__ __forceinline__ void unpack8(const u32x4 a, float* f) {
#pragma unroll
    for (int j = 0; j < 4; ++j) { f[2 * j] = bflo(a[j]); f[2 * j + 1] = bfhi(a[j]); }
}
__device__ __forceinline__ u32x4 pack8f(const float* f) { u32x4 w; w.x = cvtpk(f[0], f[1]); w.y = cvtpk(f[2], f[3]); w.z = cvtpk(f[4], f[5]); w.w = cvtpk(f[6], f[7]); return w; }
__device__ __forceinline__ void qknorm_phase(unsigned char* ws, const float* gq, const float* gk, int gw, int ngw, int lane) {
    bf16* U = (bf16*)(ws + WS_U); bf16* Q = (bf16*)(ws + WS_Q); bf16* KV = (bf16*)(ws + WS_KV);
    const float* COS = (const float*)(ws + WS_ROPE); const float* SIN = COS + SEQ * 32;
    const int h = lane >> 2, part = lane & 3;
    for (int t = gw; t < NTOK; t += ngw) {
        const int s = t & (SEQ - 1);
        const float* gqp = gq; const float* gkp = gk; asm volatile("" : "+s"(gqp), "+s"(gkp));
        char* ub = (char*)(U + (size_t)t * UCOLS); char* qb = (char*)(Q + (size_t)t * QCOLS); char* kb = (char*)(KV + (size_t)t * KVCOLS);
        const unsigned oq = (unsigned)(h * 192 + part * 32) * 2u, oq1 = (unsigned)(h * 192 + 128 + part * 8) * 2u, ok = (unsigned)(h * 256 + part * 64) * 2u;
        const unsigned opeo = (unsigned)(1024 + part * 8) * 2u, okr = (unsigned)(h * 64 + part * 8) * 2u;
        bf16* urow = (bf16*)ub; bf16* qp = (bf16*)qb + h * 192; bf16* kp = (bf16*)(kb + ok);
        const u32x4 cqv = __builtin_nontemporal_load((const u32x4*)(ub + 16u * (unsigned)lane));
        u32x4 qn[4];
#pragma unroll
        for (int i = 0; i < 4; ++i) qn[i] = __builtin_nontemporal_load((const u32x4*)(qb + oq + 16u * i));
        const u32x4 qr1 = __builtin_nontemporal_load((const u32x4*)(qb + oq1)), qr2 = __builtin_nontemporal_load((const u32x4*)(qb + oq1 + 64u));
        float cs[8], sn[8];
        { const char* cb_ = (const char*)(COS + s * 32); const char* sb_ = (const char*)(SIN + s * 32); unsigned ot = (unsigned)part * 32u; asm volatile("" : "+v"(ot));
          const f32x4 a = *(const f32x4*)(cb_ + ot), b = *(const f32x4*)(cb_ + ot + 16u), c = *(const f32x4*)(sb_ + ot), d = *(const f32x4*)(sb_ + ot + 16u);
#pragma unroll
          for (int j = 0; j < 4; ++j) { cs[j] = a[j]; cs[4 + j] = b[j]; sn[j] = c[j]; sn[4 + j] = d[j]; } }
        float rstd_q;
        { float f[8]; unpack8(cqv, f); float q = 0.f;
#pragma unroll
          for (int j = 0; j < 8; ++j) q += f[j] * f[j];
          rstd_q = __builtin_amdgcn_rsqf(wave_sum(q) * (1.f / 512.f) + EPSN); }
        { float y[32], r1[8], r2[8]; float ssq = 0.f;
#pragma unroll
          for (int i = 0; i < 4; ++i) unpack8(qn[i], y + 8 * i);
          unpack8(qr1, r1); unpack8(qr2, r2);
#pragma unroll
          for (int j = 0; j < 32; ++j) ssq += y[j] * y[j];
#pragma unroll
          for (int j = 0; j < 8; ++j) ssq += r1[j] * r1[j] + r2[j] * r2[j];
          ssq += __shfl_xor(ssq, 1); ssq += __shfl_xor(ssq, 2);
          const float scq = rstd_q * (__builtin_amdgcn_rsqf(ssq * rstd_q * rstd_q * (1.f / 192.f) + EPSN)) * QSCALE_A;
#pragma unroll
          for (int i = 0; i < 8; ++i) { const f32x4 g = *(const f32x4*)(gqp + part * 32 + 4 * i);
#pragma unroll
              for (int j = 0; j < 4; ++j) y[4 * i + j] *= scq * g[j]; }
#pragma unroll
          for (int i = 0; i < 4; ++i) *(u32x4*)(qb + oq + 16u * i) = pack8f(y + 8 * i);
          float o1[8], o2[8];
#pragma unroll
          for (int i = 0; i < 2; ++i) { const f32x4 g1 = *(const f32x4*)(gqp + 128 + part * 8 + 4 * i), g2 = *(const f32x4*)(gqp + 160 + part * 8 + 4 * i);
#pragma unroll
              for (int j = 0; j < 4; ++j) { const int e = 4 * i + j; const float y1 = r1[e] * scq * g1[j], y2 = r2[e] * scq * g2[j];
                  o1[e] = y1 * cs[e] - y2 * sn[e]; o2[e] = y2 * cs[e] + y1 * sn[e]; } }
          *(u32x4*)(qb + oq1) = pack8f(o1); *(u32x4*)(qb + oq1 + 64u) = pack8f(o2); }
        __builtin_amdgcn_sched_barrier(0);
        const u32x4 ckvv = __builtin_nontemporal_load((const u32x4*)(ub + 1024u + 16u * (unsigned)lane));
        const u32x4 pe1 = __builtin_nontemporal_load((const u32x4*)(ub + opeo)), pe2 = __builtin_nontemporal_load((const u32x4*)(ub + opeo + 64u));
        u32x4 kvv[8];
#pragma unroll
        for (int i = 0; i < 8; ++i) kvv[i] = __builtin_nontemporal_load((const u32x4*)(kb + ok + 16u * i));
        float rstd_kv, ssq_pe;
        { float f[8]; unpack8(ckvv, f); float q = 0.f;
#pragma unroll
          for (int j = 0; j < 8; ++j) q += f[j] * f[j];
          rstd_kv = __builtin_amdgcn_rsqf(wave_sum(q) * (1.f / 512.f) + EPSN); }
        float x1[8], x2[8]; unpack8(pe1, x1); unpack8(pe2, x2);
        { float q = 0.f;
#pragma unroll
          for (int j = 0; j < 8; ++j) q += x1[j] * x1[j] + x2[j] * x2[j];
          q += __shfl_xor(q, 1); q += __shfl_xor(q, 2); ssq_pe = q; }
        { float ssq = 0.f;
#pragma unroll
          for (int i = 0; i < 8; ++i) { float f[8]; unpack8(kvv[i], f);
#pragma unroll
              for (int j = 0; j < 8; ++j) ssq += f[j] * f[j]; }
          ssq = part < 2 ? ssq : 0.f;
          ssq += __shfl_xor(ssq, 1); ssq += __shfl_xor(ssq, 2);
          const float rk = __builtin_amdgcn_rsqf((ssq * rstd_kv * rstd_kv + ssq_pe) * (1.f / 192.f) + EPSN);
          const float sck = part < 2 ? rstd_kv * rk : rstd_kv;
#pragma unroll
          for (int i = 0; i < 8; ++i) { float f[8]; unpack8(kvv[i], f);
              f32x4 g0 = *(const f32x4*)(gkp + (part & 1) * 64 + 8 * i), g1 = *(const f32x4*)(gkp + (part & 1) * 64 + 8 * i + 4);
              if (part >= 2) { g0 = (f32x4){1.f, 1.f, 1.f, 1.f}; g1 = g0; }
#pragma unroll
              for (int j = 0; j < 4; ++j) { f[j] *= sck * g0[j]; f[4 + j] *= sck * g1[j]; }
              *(u32x4*)(kb + ok + 16u * i) = pack8f(f); }
          float o1[8], o2[8];
#pragma unroll
          for (int i = 0; i < 2; ++i) { const f32x4 g1 = *(const f32x4*)(gkp + 128 + part * 8 + 4 * i), g2 = *(const f32x4*)(gkp + 160 + part * 8 + 4 * i);
#pragma unroll
              for (int j = 0; j < 4; ++j) { const int e = 4 * i + j; const float y1 = x1[e] * rk * g1[j], y2 = x2[e] * rk * g2[j];
                  o1[e] = y1 * cs[e] - y2 * sn[e]; o2[e] = y2 * cs[e] + y1 * sn[e]; } }
          *(u32x4*)(ub + okr) = pack8f(o1); *(u32x4*)(ub + okr + 64u) = pack8f(o2); }
    }
}

#define SBAR() __builtin_amdgcn_sched_barrier(0)
__device__ __forceinline__ int v_st(int k, int c) { const int kk = (k & ~0xC) | ((k & 4) << 1) | ((k & 8) >> 1); return ((kk >> 3) * 4 + (c >> 5)) * 512 + ((kk & 7) * 32 + (c & 31)) * 2; }
__device__ __forceinline__ int v_rd_base(int lane) { return ((lane & 3) << 3) | (((lane >> 2) & 3) << 6) | (((lane >> 4) & 1) << 5) | (((lane >> 5) & 1) << 8); }
__device__ __forceinline__ int crow(int r, int hi) { return (r & 3) + 8 * (r >> 2) + 4 * hi; }
#define PK4(P, B_, OUT) do { unsigned a0 = cvtpk(P[B_+0], P[B_+1]), a1 = cvtpk(P[B_+2], P[B_+3]);                          \
        unsigned b0 = cvtpk(P[B_+4], P[B_+5]), b1 = cvtpk(P[B_+6], P[B_+7]);                                             \
        auto r0 = __builtin_amdgcn_permlane32_swap(a0, b0, false, false); auto r1 = __builtin_amdgcn_permlane32_swap(a1, b1, false, false); \
        u32x4 w = {r0[0], r1[0], r0[1], r1[1]}; OUT = *reinterpret_cast<bf16x8*>(&w); } while (0)
#define TRRD(dst, off) asm volatile("ds_read_b64_tr_b16 %0, %1 offset:%2" : "=&v"(dst) : "v"(vb0), "i"(off) : "memory")

namespace mla {
constexpr int SHM_V = 16384, SHM_K = 24576, OFF_K = 3 * SHM_V, OFF_WS = OFF_K + 3 * SHM_K;
__device__ __forceinline__ int kswz(int row, int colB) { return row * 384 + (colB ^ (((row >> 1) & 7) << 4)); }
#define MBAR() asm volatile("s_waitcnt lgkmcnt(0)\n\ts_barrier" ::: "memory")
__device__ __forceinline__ void qkt(f32x16& p0, f32x16& p1, const char* kbuf, const int* koff, const bf16x8* qr) {
    p0 = f32x16{}; p1 = f32x16{};
    int ka[4];
#pragma unroll
    for (int dd = 0; dd < 4; ++dd) ka[dd] = (int)(uintptr_t)kbuf + koff[dd];
    bf16x8 X0, X1, Y0, Y1, Z0, Z1;
#define KRD(S, s_) asm volatile("ds_read_b128 %0, %2 offset:%3\n\tds_read_b128 %1, %2 offset:%4" : "=&v"(S##0), "=&v"(S##1) : "v"(ka[(s_) & 3]), "i"(((s_) >> 2) * 128), "i"(((s_) >> 2) * 128 + 12288) : "memory")
#define KMM(S, s_) do { p0 = __builtin_amdgcn_mfma_f32_32x32x16_bf16(S##0, qr[s_], p0, 0, 0, 0); p1 = __builtin_amdgcn_mfma_f32_32x32x16_bf16(S##1, qr[s_], p1, 0, 0, 0); } while (0)
    KRD(X, 0); KRD(Y, 1);
    KRD(Z, 2); asm volatile("s_waitcnt lgkmcnt(4)" ::: "memory"); SBAR(); KMM(X, 0); SBAR();
    KRD(X, 3); asm volatile("s_waitcnt lgkmcnt(4)" ::: "memory"); SBAR(); KMM(Y, 1); SBAR();
    KRD(Y, 4); asm volatile("s_waitcnt lgkmcnt(4)" ::: "memory"); SBAR(); KMM(Z, 2); SBAR();
    KRD(Z, 5); asm volatile("s_waitcnt lgkmcnt(4)" ::: "memory"); SBAR(); KMM(X, 3); SBAR();
    KRD(X, 6); asm volatile("s_waitcnt lgkmcnt(4)" ::: "memory"); SBAR(); KMM(Y, 4); SBAR();
    KRD(Y, 7); asm volatile("s_waitcnt lgkmcnt(4)" ::: "memory"); SBAR(); KMM(Z, 5); SBAR();
    KRD(Z, 8); asm volatile("s_waitcnt lgkmcnt(4)" ::: "memory"); SBAR(); KMM(X, 6); SBAR();
    KRD(X, 9); asm volatile("s_waitcnt lgkmcnt(4)" ::: "memory"); SBAR(); KMM(Y, 7); SBAR();
    KRD(Y, 10); asm volatile("s_waitcnt lgkmcnt(4)" ::: "memory"); SBAR(); KMM(Z, 8); SBAR();
    KRD(Z, 11); asm volatile("s_waitcnt lgkmcnt(4)" ::: "memory"); SBAR(); KMM(X, 9); SBAR();
    asm volatile("s_waitcnt lgkmcnt(2)" ::: "memory"); SBAR(); KMM(Y, 10); SBAR();
    asm volatile("s_waitcnt lgkmcnt(0)" ::: "memory"); SBAR(); KMM(Z, 11); SBAR();
#undef KRD
#undef KMM
}
__device__ __forceinline__ void pv_tile(f32x16* o, int vb0, bf16x8 pa0, bf16x8 pa1, bf16x8 pa2, bf16x8 pa3) {
    s16x4 A0, A1, A2, A3, A4, A5, A6, A7, B0, B1, B2, B3, B4, B5, B6, B7;
#define RD8(S, d0) do { constexpr int b_ = (d0) * 512; TRRD(S##0, b_); TRRD(S##1, b_ + 2048); TRRD(S##2, b_ + 4096); TRRD(S##3, b_ + 6144); \
        TRRD(S##4, b_ + 8192); TRRD(S##5, b_ + 10240); TRRD(S##6, b_ + 12288); TRRD(S##7, b_ + 14336); } while (0)
#define MM4(S, d0) do { \
        o[d0] = __builtin_amdgcn_mfma_f32_32x32x16_bf16(pa0, (bf16x8){S##0[0], S##0[1], S##0[2], S##0[3], S##1[0], S##1[1], S##1[2], S##1[3]}, o[d0], 0, 0, 0); \
        o[d0] = __builtin_amdgcn_mfma_f32_32x32x16_bf16(pa1, (bf16x8){S##2[0], S##2[1], S##2[2], S##2[3], S##3[0], S##3[1], S##3[2], S##3[3]}, o[d0], 0, 0, 0); \
        o[d0] = __builtin_amdgcn_mfma_f32_32x32x16_bf16(pa2, (bf16x8){S##4[0], S##4[1], S##4[2], S##4[3], S##5[0], S##5[1], S##5[2], S##5[3]}, o[d0], 0, 0, 0); \
        o[d0] = __builtin_amdgcn_mfma_f32_32x32x16_bf16(pa3, (bf16x8){S##6[0], S##6[1], S##6[2], S##6[3], S##7[0], S##7[1], S##7[2], S##7[3]}, o[d0], 0, 0, 0); } while (0)
    RD8(A, 0);
    RD8(B, 1); asm volatile("s_waitcnt lgkmcnt(8)" ::: "memory"); SBAR(); MM4(A, 0); SBAR();
    RD8(A, 2); asm volatile("s_waitcnt lgkmcnt(8)" ::: "memory"); SBAR(); MM4(B, 1); SBAR();
    RD8(B, 3); asm volatile("s_waitcnt lgkmcnt(8)" ::: "memory"); SBAR(); MM4(A, 2); SBAR();
    asm volatile("s_waitcnt lgkmcnt(0)" ::: "memory"); SBAR(); MM4(B, 3);
#undef RD8
#undef MM4
}
__device__ __forceinline__ void block(int b, int h, int qb, unsigned char* ws, char* lds, int grp, int wid) {
    const bf16* Q = (const bf16*)(ws + WS_Q); const bf16* KV = (const bf16*)(ws + WS_KV); const bf16* KR = (const bf16*)(ws + WS_KR); const bf16* U = (const bf16*)(ws + WS_U); bf16* OG = (bf16*)(ws + WS_XN);
    const int lane = lane_id(), tid = wid * 64 + lane, r32 = lane & 31, hi = lane >> 5;
    const size_t tb = (size_t)b * SEQ;
    const int qlo = qb * 256 + wid * 32;
    char* V_lds = lds; char* K_lds = lds + OFF_K;
    float* wsf = (float*)(lds + OFF_WS) + wid * 64; float* li_l = wsf; float* al_l = wsf + 32;
    bf16x8 qr[12];
    { const bf16* qp = Q + (tb + qlo + r32) * QCOLS + h * 192 + hi * 8;
#pragma unroll
      for (int d0 = 0; d0 < 12; ++d0) qr[d0] = *(const bf16x8*)(qp + d0 * 16); }
    const int NT = (qb + 1) * 4;
    unsigned ko[3], ki[3], vo[2];
#pragma unroll
    for (int j = 0; j < 3; ++j) { const int pos = 1024 * (3 * wid + j) + 16 * lane, row = pos / 384, slot = (pos - row * 384) >> 4;
        const int ch = (slot & ~7) | ((slot & 7) ^ ((row >> 1) & 7));
        if (ch < 16) { ko[j] = (unsigned)WS_KV + (unsigned)((tb + row) * KVCOLS + h * 256 + ch * 8) * 2u; ki[j] = 64u * KVCOLS * 2u; }
        else { ko[j] = (unsigned)WS_U + (unsigned)((tb + row) * UCOLS + h * 64 + (ch - 16) * 8) * 2u; ki[j] = 64u * UCOLS * 2u; } }
#pragma unroll
    for (int j = 0; j < 2; ++j) { const int pos = 1024 * (2 * wid + j) + 16 * lane, st = pos >> 9, kk = (st >> 2) * 8 + ((pos & 511) >> 6), c = (st & 3) * 32 + ((pos & 63) >> 4) * 8;
        const int k = (kk & ~0xC) | ((kk & 4) << 1) | ((kk & 8) >> 1);
        vo[j] = (unsigned)WS_KV + (unsigned)((tb + k) * KVCOLS + h * 256 + 128 + c) * 2u; }
    const int vb0 = (int)(uintptr_t)V_lds + v_rd_base(lane);
    int koff[4];
#pragma unroll
    for (int dd = 0; dd < 4; ++dd) koff[dd] = kswz(r32, (dd * 16 + hi * 8) * 2);
    LAS unsigned char* ldsK = (LAS unsigned char*)K_lds + wid * 3072; LAS unsigned char* ldsV = (LAS unsigned char*)V_lds + wid * 2048;
#define DMAK(bo_) do { _Pragma("unroll") for (int j_ = 0; j_ < 3; ++j_) { \
        __builtin_amdgcn_global_load_lds((const unsigned*)(ws + ko[j_]), (LAS unsigned*)(ldsK + (bo_) + j_ * 1024), 16, 0, 0); ko[j_] += ki[j_]; } } while (0)
#define DMAV(bo_) do { _Pragma("unroll") for (int j_ = 0; j_ < 2; ++j_) { \
        __builtin_amdgcn_global_load_lds((const unsigned*)(ws + vo[j_]), (LAS unsigned*)(ldsV + (bo_) + j_ * 1024), 16, 0, 0); vo[j_] += 64u * KVCOLS * 2u; } } while (0)
#define VMW0() asm volatile("s_waitcnt vmcnt(0)" ::: "memory")
    float m_reg = -1e30f, l_reg = 0.f; f32x16 o[4] = {};
    DMAK(0); DMAV(0); DMAK(SHM_K);
    VMW0(); MBAR();
    if (grp == 1) MBAR();
    int kcur = 0, kp2 = 2 * SHM_K;
    int vcur = 0, vnext = SHM_V;
    bf16x8 pa0, pa1, pa2, pa3; f32x16 p0, p1;
#define VALU_HALF(t) do { \
        SBAR(); if ((t) + 2 < NT) DMAK(kp2); if ((t) + 1 < NT) DMAV(vnext); SBAR(); \
        if (64 * (t) + 63 > qlo) { const int dq = qlo + r32 - 4 * hi - 64 * (t); const float NEG = -__builtin_inff(); \
            _Pragma("unroll") for (int r = 0; r < 16; ++r) { const int c = (r & 3) + 8 * (r >> 2); if (dq - c < 0) p0[r] = NEG; if (dq - c - 32 < 0) p1[r] = NEG; } } \
        float pmax = p0[0]; \
        _Pragma("unroll") for (int r = 1; r < 16; ++r) pmax = fmaxf(pmax, p0[r]); \
        _Pragma("unroll") for (int r = 0; r < 16; ++r) pmax = fmaxf(pmax, p1[r]); \
        { auto rr = __builtin_amdgcn_permlane32_swap(__float_as_uint(pmax), __float_as_uint(pmax), false, false); pmax = fmaxf(__uint_as_float(rr[0]), __uint_as_float(rr[1])); } \
          \
        const bool grow_ = __any(pmax > m_reg + 8.0f); \
        const float mn = grow_ ? fmaxf(m_reg, pmax) : m_reg; const float alpha = grow_ ? __builtin_amdgcn_exp2f(m_reg - mn) : 1.0f; m_reg = mn; \
        float ps = 0.f; \
        _Pragma("unroll") for (int r = 0; r < 16; ++r) { p0[r] = __builtin_amdgcn_exp2f(p0[r] - mn); ps += p0[r]; } \
        _Pragma("unroll") for (int r = 0; r < 16; ++r) { p1[r] = __builtin_amdgcn_exp2f(p1[r] - mn); ps += p1[r]; } \
        { auto rr = __builtin_amdgcn_permlane32_swap(__float_as_uint(ps), __float_as_uint(ps), false, false); ps = __uint_as_float(rr[0]) + __uint_as_float(rr[1]); } \
        l_reg = l_reg * alpha + ps; \
        PK4(p0, 0, pa0); PK4(p0, 8, pa1); PK4(p1, 0, pa2); PK4(p1, 8, pa3); \
        if (grow_) { if (hi == 0) al_l[r32] = alpha; asm volatile("s_waitcnt lgkmcnt(0)" ::: "memory"); \
            _Pragma("unroll") for (int d_ = 0; d_ < 4; ++d_) _Pragma("unroll") for (int r = 0; r < 16; ++r) o[d_][r] *= al_l[crow(r, hi)]; } \
        MBAR(); } while (0)
    qkt(p0, p1, K_lds + kcur, koff, qr);
    VMW0(); MBAR();
    for (int t = 0; t + 1 < NT; ++t) {
        VALU_HALF(t);
        kcur = (kcur == 2 * SHM_K) ? 0 : kcur + SHM_K; kp2 = (kp2 == 2 * SHM_K) ? 0 : kp2 + SHM_K;
        pv_tile(o, vb0 + vcur, pa0, pa1, pa2, pa3);
        qkt(p0, p1, K_lds + kcur, koff, qr);
        VMW0(); MBAR();
        vcur = vnext; vnext = (vnext == 2 * SHM_V) ? 0 : vnext + SHM_V;
    }
    VALU_HALF(NT - 1);
    pv_tile(o, vb0 + vcur, pa0, pa1, pa2, pa3);
    MBAR();
    if (grp == 0) MBAR();
#undef VALU_HALF
#undef DMAK
#undef DMAV
#undef VMW0
    { int le = lane; asm volatile("" : "+v"(le)); const int r32e = le & 31, hie = le >> 5;
      if (hie == 0) li_l[r32e] = l_reg; asm volatile("s_waitcnt lgkmcnt(0)" ::: "memory");
#pragma unroll
      for (int r = 0; r < 16; ++r) { const size_t row = tb + qlo + crow(r, hie); const float rl = __builtin_amdgcn_rcpf(li_l[crow(r, hie)]);
#pragma unroll
        for (int d0 = 0; d0 < 4; ++d0) { const int col = h * 128 + d0 * 32 + r32e;
            const float g = bf2f(U[row * UCOLS + 1088 + col]);
            OG[row * DM + col] = f2bf(o[d0][r] * rl * silu_f(g)); } } }
    MBAR();
}
__device__ __forceinline__ void phase(unsigned char* ws, char* lds, int wid) {
    const int G = gridDim.x, bx = blockIdx.x; const int vcu = (G % 8 == 0) ? (bx % 8) * (G / 8) + bx / 8 : bx;
    int grp;
    { unsigned* cnt = (unsigned*)(lds + OFF_WS + 2048);
      const int lane0 = lane_id();
      if (wid == 0 && lane0 < 4) cnt[lane0] = 0u;
      __syncthreads();
      const unsigned simd = (unsigned)__builtin_amdgcn_s_getreg((1 << 11) | (4 << 6) | 4) & 3u;
      unsigned g = 0u; if (lane0 == 0) g = atomicAdd(&cnt[simd], 1u);
      grp = (int)(__builtin_amdgcn_readfirstlane(g) & 1u);
      __syncthreads(); }
    for (int L = vcu; L < 1024; L += G) { const int bh = L >> 5, x = L & 31;
        for (int pass = 0; pass < 2; ++pass) block(bh >> 4, bh & 15, pass ? x : 63 - x, ws, lds, grp, wid);     }
}
}

namespace dil {
__device__ __forceinline__ void wave_item(int w, int gi, const bf16* Gb, const float* gqn, const float* gkn, bf16* OP, float* LSE, char* wlds, int lane) {
    const int r32 = lane & 31, hi = lane >> 5;
    const int sb = w & 511, grp = w >> 9, br = grp % 3, hh = (grp / 3) & 3, b = grp / 12;
    const int dsh = 2 * br, d = 1 << dsh;
    const int nblk = 512 >> dsh, res = sb / nblk, blk = sb % nblk, n0 = blk * 32;
    const size_t tb = (size_t)b * SEQ;
    const int hcol = hh * 1152 + br * 128;
    float* rk_l = (float*)(wlds + 8192); float* al_l = rk_l + 32; float* li_l = al_l + 32;
    const int vb0 = (int)(uintptr_t)wlds + v_rd_base(lane);
    bf16x8 qr[8];
    { const bf16* qp = Gb + (tb + (size_t)(n0 + r32) * d + res) * GCOLS + hcol + hi * 8;
#pragma unroll
      for (int d0 = 0; d0 < 8; ++d0) qr[d0] = *(const bf16x8*)(qp + d0 * 16); }
    const int hg = gi * 4 + hh;
    const float ab = exp2f(-0.5f * (float)(hg + 1)) * (float)d * LOG2E;
    float m_reg = -1e30f, l_reg = 0.f; f32x16 o[4] = {};
    const int jfirst = n0 >= 128 ? 0 : ((128 - n0) >> 5);
    const bf16* kcol = Gb + hcol + 384 + hi * 8; const bf16* vcol = Gb + hcol + 768 + (lane & 15) * 8;
    bf16x8 kf[8]; u32x4 vv[8];
#define DIL_LOAD(j_) do { const int kb_ = n0 - 128 + 32 * (j_); \
        { int nk = kb_ + r32; nk = nk < 0 ? 0 : nk; const bf16* kp = kcol + (tb + (size_t)nk * d + res) * GCOLS; \
          _Pragma("unroll") for (int d0 = 0; d0 < 8; ++d0) kf[d0] = *(const bf16x8*)(kp + d0 * 16); } \
        _Pragma("unroll") for (int i = 0; i < 8; ++i) { int nk = kb_ + (lane >> 4) + 4 * i; nk = nk < 0 ? 0 : nk; \
            vv[i] = *(const u32x4*)(vcol + (tb + (size_t)nk * d + res) * GCOLS); } } while (0)
    DIL_LOAD(jfirst);
    for (int j = jfirst; j < 5; ++j) {
        const int kbase = n0 - 128 + 32 * j;
#pragma unroll
        for (int i = 0; i < 8; ++i) *(u32x4*)(wlds + v_st((lane >> 4) + 4 * i, (lane & 15) * 8)) = vv[i];
        f32x16 p0 = f32x16{};
#pragma unroll
        for (int d0 = 0; d0 < 8; ++d0) p0 = __builtin_amdgcn_mfma_f32_32x32x16_bf16(kf[d0], qr[d0], p0, 0, 0, 0);
        SBAR();
        if (j + 1 < 5) DIL_LOAD(j + 1);
        SBAR();
        asm volatile("s_waitcnt lgkmcnt(0)" ::: "memory");
        const float NEG = -__builtin_inff();
        float pmax = NEG;
#pragma unroll
        for (int r = 0; r < 16; ++r) { const int kc = crow(r, hi); const int nk = kbase + kc; const int rel = n0 + r32 - nk;
            float sv = p0[r] - ab * (float)rel;
            if (rel < 0 || rel > 128 || nk < 0) sv = NEG;
            p0[r] = sv; pmax = fmaxf(pmax, sv); }
        { auto rr = __builtin_amdgcn_permlane32_swap(__float_as_uint(pmax), __float_as_uint(pmax), false, false); pmax = fmaxf(__uint_as_float(rr[0]), __uint_as_float(rr[1])); }
        const float mn = fmaxf(m_reg, pmax); const float alpha = __builtin_amdgcn_exp2f(m_reg - mn); m_reg = mn;
        float ps = 0.f;
#pragma unroll
        for (int r = 0; r < 16; ++r) { p0[r] = __builtin_amdgcn_exp2f(p0[r] - mn); ps += p0[r]; }
        { auto rr = __builtin_amdgcn_permlane32_swap(__float_as_uint(ps), __float_as_uint(ps), false, false); ps = __uint_as_float(rr[0]) + __uint_as_float(rr[1]); }
        l_reg = l_reg * alpha + ps;
        bf16x8 pa0, pa1; PK4(p0, 0, pa0); PK4(p0, 8, pa1);
        if (__any(alpha < 1.f)) { if (hi == 0) al_l[r32] = alpha; asm volatile("s_waitcnt lgkmcnt(0)" ::: "memory");
#pragma unroll
            for (int d_ = 0; d_ < 4; ++d_)
#pragma unroll
                for (int r = 0; r < 16; ++r) o[d_][r] *= al_l[crow(r, hi)]; }
#define PV2(d0) do { s16x4 l0, l1, h0, h1; constexpr int b_ = (d0) * 512; \
        TRRD(l0, b_); TRRD(h0, b_ + 2048); TRRD(l1, b_ + 4096); TRRD(h1, b_ + 6144); \
        asm volatile("s_waitcnt lgkmcnt(0)" ::: "memory"); SBAR(); \
        o[d0] = __builtin_amdgcn_mfma_f32_32x32x16_bf16(pa0, (bf16x8){l0[0], l0[1], l0[2], l0[3], h0[0], h0[1], h0[2], h0[3]}, o[d0], 0, 0, 0);   \
        o[d0] = __builtin_amdgcn_mfma_f32_32x32x16_bf16(pa1, (bf16x8){l1[0], l1[1], l1[2], l1[3], h1[0], h1[1], h1[2], h1[3]}, o[d0], 0, 0, 0); } while (0)
        PV2(0); PV2(1); PV2(2); PV2(3);
#undef PV2
    }
#undef DIL_LOAD
    if (hi == 0) { li_l[r32] = l_reg; LSE[((size_t)br * NTOK + tb + (size_t)(n0 + r32) * d + res) * 4 + hh] = m_reg + __builtin_amdgcn_logf(l_reg); }
    asm volatile("s_waitcnt lgkmcnt(0)" ::: "memory");
    bf16* op = OP + (size_t)br * NTOK * 512;
    float rl[16];
#pragma unroll
    for (int r = 0; r < 16; ++r) rl[r] = __builtin_amdgcn_rcpf(li_l[crow(r, hi)]);
    asm volatile("s_waitcnt lgkmcnt(0)" ::: "memory");
#pragma unroll
    for (int r = 0; r < 16; ++r) { const int qc = crow(r, hi);
#pragma unroll
        for (int d0 = 0; d0 < 4; ++d0) *(unsigned short*)(wlds + qc * 272 + (d0 * 32 + r32) * 2) = f2bf(o[d0][r] * rl[r]); }
    asm volatile("s_waitcnt lgkmcnt(0)" ::: "memory");
#pragma unroll
    for (int i = 0; i < 8; ++i) { const int q = (lane >> 4) + 4 * i; const u32x4 v = *(const u32x4*)(wlds + q * 272 + (lane & 15) * 16);
        const size_t row = tb + (size_t)(n0 + q) * d + res; *(u32x4*)(op + row * 512 + hh * 128 + (lane & 15) * 8) = v; }
    asm volatile("s_waitcnt lgkmcnt(0)" ::: "memory");
}
}

__global__ void __launch_bounds__(512, 2) yoco_fwd(Args args) {
    extern __shared__ __attribute__((aligned(16))) unsigned char lds[];
    cg::grid_group grid = cg::this_grid();
    const int wave = __builtin_amdgcn_readfirstlane((int)threadIdx.x >> 6);
#define lane lane_id()
    const int G = gridDim.x; const int gw = blockIdx.x * 8 + wave, ngw = G * 8;
    unsigned char* ws = args.ws;
    const int lo = args.ph_lo, hi = args.ph_hi;
#define IN(k) (lo <= (k) && (k) < hi)
#define SEAM(k) do { if ((k) + 1 < hi) grid.sync(); } while (0)
    if (IN(0)) {
      for (int rep = 0; rep < (DUP == 100 ? 2 : 1); ++rep) {
        LAS float* scr = (LAS float*)((LAS unsigned char*)lds + wave * 16384);
        int base = 0;
#define TR_MAT(Wp, Kc, Nc, Gp, Tp, Mp) do { const int ni = ((Kc) / 64) * ((Nc) / 32); int first = (gw - base) % ngw; if (first < 0) first += ngw; \
            for (int it = first; it < ni; it += ngw) transpose_item((Wp), (Kc), (Nc), (Gp), (Tp), (Mp), scr, it, lane); base += ni; } while (0)
        TR_MAT(args.in[2], 2048, 3136, args.in[1], (bf16*)(ws + WS_WAIN), 0);
        TR_MAT(args.in[4], 512, 3072, args.in[3], (bf16*)(ws + WS_WQUP), 0);
        TR_MAT(args.in[6], 512, 4096, args.in[5], (bf16*)(ws + WS_WKVUP), 0);
        TR_MAT(args.in[9], 2048, 2048, (const float*)nullptr, (bf16*)(ws + WS_WAO), 0);
        TR_MAT(args.in[11], 2048, 12288, args.in[10], (bf16*)(ws + WS_WBALL), 1);
        TR_MAT(args.in[14], 2048, 8192, args.in[13], (bf16*)(ws + WS_WBALL), 2);
        TR_MAT(args.in[16], 2048, 2048, (const float*)nullptr, (bf16*)(ws + WS_WBO), 0);
#undef TR_MAT
        for (int m = gw; m < NTOK; m += 2 * ngw) { if (m + ngw < NTOK) norm_row2<true>(args.in[0] + (size_t)m * DM, (bf16*)(ws + WS_XN) + (size_t)m * DM, args.in[0] + (size_t)(m + ngw) * DM, (bf16*)(ws + WS_XN) + (size_t)(m + ngw) * DM, lane);
            else norm_row(args.in[0] + (size_t)m * DM, (bf16*)(ws + WS_XN) + (size_t)m * DM, lane); }
        { float* COS = (float*)(ws + WS_ROPE); float* SIN = COS + SEQ * 32;
          for (int idx = gw * 64 + lane; idx < SEQ * 32; idx += ngw * 64) { float c, sn; sincos_pos(idx >> 5, idx & 31, c, sn); COS[idx] = c; SIN[idx] = sn; } }
      }
        SEAM(0);
    }
    if (IN(1)) {
        const pg8::Gemm g{(bf16*)(ws + WS_XN), (bf16*)(ws + WS_WAIN), NTOK, UCOLS, 2048, 2048};
        const pg8::EpiSt E{(bf16*)(ws + WS_U), UCOLS, 1 << 30, nullptr, 0, 0};
        pg8::StaticOrder S; S.init(g.M, g.N, G, (int)blockIdx.x);
#ifndef SK_G1
        for (int rep = 0; rep < (DUP == 1 ? 2 : 1); ++rep)
        pg8::gemm_phase<pg8::EpiSt, pg8::StaticOrder, true, true, 2048, 2048>((LAS unsigned char*)lds, g, S, E, wave);
#endif
        SEAM(1);
    }
    if (IN(2)) {
        for (int cj = 0; cj < (DUP == 2 ? 4 : 2); ++cj) { const int ci = cj & 1;
            const pg8::Gemm g{(bf16*)(ws + WS_U) + (ci ? 512 : 0), (bf16*)(ws + (ci ? WS_WKVUP : WS_WQUP)), NTOK, ci ? KVCOLS : QCOLS, 512, UCOLS};
            const pg8::EpiSt E{(bf16*)(ws + (ci ? WS_KV : WS_Q)), ci ? KVCOLS : QCOLS, 1 << 30, nullptr, 0, 0};
            pg8::StaticOrder S; S.init(g.M, g.N, G, (int)blockIdx.x);
#ifndef SK_G1
            pg8::gemm_phase<pg8::EpiSt, pg8::StaticOrder, true, true, 512, UCOLS>((LAS unsigned char*)lds, g, S, E, wave);
#endif
        }
        SEAM(2);
    }
    if (IN(3)) {
#ifndef SK_QKN
        { int l3 = lane; asm volatile("" : "+v"(l3)); qknorm_phase(ws, args.in[7], args.in[8], gw, ngw, l3); }
#endif
        SEAM(3);
    }
    if (IN(4)) {
#ifndef SK_MLA
        for (int rep = 0; rep < (DUP == 4 ? 2 : 1); ++rep) mla::phase(ws, (char*)lds, wave);
#endif
        SEAM(4);
    }
    if (IN(5)) {
        const pg8::Gemm g{(bf16*)(ws + WS_XN), (bf16*)(ws + WS_WAO), NTOK, DM, 2048, 2048};
        const pg8::EpiRes E{args.in[0], args.out, DM, true, false};
        pg8::StaticOrder S; S.init(g.M, g.N, G, (int)blockIdx.x);
#ifndef SK_G2
        for (int rep = 0; rep < (DUP == 5 ? 2 : 1); ++rep)
        pg8::gemm_phase<pg8::EpiRes, pg8::StaticOrder, true, true, 2048, 2048>((LAS unsigned char*)lds, g, S, E, wave);
#endif
        SEAM(5);
    }
    if (IN(6)) {
        if (DUP == 66) { for (int rep = 0; rep < 20; ++rep) grid.sync(); }
        for (int rep = 0; rep < (DUP == 6 ? 2 : 1); ++rep)
        for (int m = gw; m < NTOK; m += 2 * ngw) { if (m + ngw < NTOK) norm_row2<true>(args.out + (size_t)m * DM, (bf16*)(ws + WS_XN) + (size_t)m * DM, args.out + (size_t)(m + ngw) * DM, (bf16*)(ws + WS_XN) + (size_t)(m + ngw) * DM, lane);
            else norm_row(args.out + (size_t)m * DM, (bf16*)(ws + WS_XN) + (size_t)m * DM, lane); }
        SEAM(6);
    }
    for (int it = 0; it < (DUP == 7 ? 8 : 4); ++it) { const int gi = it & 3;
        if (IN(7 + 3 * gi)) {
            const pg8::Gemm g{(bf16*)(ws + WS_XN), (bf16*)(ws + WS_WBALL) + (size_t)gi * GN * 2048, NTOK, GN, 2048, 2048};
            const pg8::EpiStNorm E{(bf16*)(ws + WS_G), GCOLS, 18, (bf16*)(ws + WS_GATE), DM, gi * 512, args.in[15], args.in[12], (LAS float*)((LAS unsigned char*)lds + 131072), QSCALE_B, EPSN};
            pg8::StaticOrder S; S.init(g.M, g.N, G, (int)blockIdx.x);
#ifndef SK_G1
            pg8::gemm_phase<pg8::EpiStNorm, pg8::StaticOrder, true, true, 2048, 2048>((LAS unsigned char*)lds, g, S, E, wave);
#endif
            SEAM(7 + 3 * gi);
        }
        if (IN(8 + 3 * gi)) {
#ifndef SK_DIL
            int lane2 = lane; asm volatile("" : "+v"(lane2));
            char* wlds = (char*)lds + wave * 16384;
            const int gwx = (G % 8 == 0) ? ((int)(blockIdx.x & 7) * (G / 8) + (int)(blockIdx.x >> 3)) * 8 + wave : gw;
            for (int rep = 0; rep < (DUP == 8 ? 2 : 1); ++rep)
            for (int w = gwx; w < 12288; w += ngw)
                dil::wave_item(w, gi, (const bf16*)(ws + WS_G), args.in[15], args.in[12], (bf16*)(ws + WS_OP), (float*)(ws + WS_LSE), wlds, lane2);
#endif
            SEAM(8 + 3 * gi);
        }
        if (IN(9 + 3 * gi)) {
            int lane2 = lane; asm volatile("" : "+v"(lane2));
            const int hh = lane2 >> 4, e0 = 8 * (lane2 & 15);
            const bf16* OP = (const bf16*)(ws + WS_OP); const float* LSE = (const float*)(ws + WS_LSE);
            const bf16* GATE = (const bf16*)(ws + WS_GATE); bf16* OG = (bf16*)(ws + WS_OG);
            for (int t0 = gw; t0 < NTOK; t0 += 2 * ngw) {
                float ls[2][3]; u32x4 ov[2][3], gv[2]; size_t oc[2]; bool ok[2];
#pragma unroll
                for (int k = 0; k < 2; ++k) { const int t = t0 + k * ngw; ok[k] = t < NTOK; const int tc = ok[k] ? t : t0;
                    oc[k] = (size_t)tc * DM + (gi * 4 + hh) * 128 + e0;
#pragma unroll
                    for (int br = 0; br < 3; ++br) { ls[k][br] = __builtin_nontemporal_load(LSE + ((size_t)br * NTOK + tc) * 4 + hh); ov[k][br] = __builtin_nontemporal_load((const u32x4*)(OP + ((size_t)br * NTOK + tc) * 512 + hh * 128 + e0)); }
                    gv[k] = __builtin_nontemporal_load((const u32x4*)(GATE + oc[k])); }
#pragma unroll
                for (int k = 0; k < 2; ++k) {
                    const float mx = fmaxf(ls[k][0], fmaxf(ls[k][1], ls[k][2]));
                    float w0 = __builtin_amdgcn_exp2f(ls[k][0] - mx), w1 = __builtin_amdgcn_exp2f(ls[k][1] - mx), w2 = __builtin_amdgcn_exp2f(ls[k][2] - mx);
                    const float inv = __builtin_amdgcn_rcpf(w0 + w1 + w2); w0 *= inv; w1 *= inv; w2 *= inv;
                    u32x4 res;
#pragma unroll
                    for (int j = 0; j < 4; ++j) {
                        const float a = w0 * bflo(ov[k][0][j]) + w1 * bflo(ov[k][1][j]) + w2 * bflo(ov[k][2][j]);
                        const float c = w0 * bfhi(ov[k][0][j]) + w1 * bfhi(ov[k][1][j]) + w2 * bfhi(ov[k][2][j]);
                        res[j] = cvtpk(a * silu_f(bflo(gv[k][j])), c * silu_f(bfhi(gv[k][j]))); }
                    if (ok[k]) *(u32x4*)(OG + oc[k]) = res; }
            }
            if (gi == 3) SEAM(9 + 3 * gi);
        }
    }
    if (IN(19)) {
        const pg8::Gemm g{(bf16*)(ws + WS_OG), (bf16*)(ws + WS_WBO), NTOK, DM, 2048, 2048};
        const pg8::EpiRes E{args.out, args.out, DM, true, true};
        pg8::StaticOrder S; S.init(g.M, g.N, G, (int)blockIdx.x);
#ifndef SK_G2
        pg8::gemm_phase<pg8::EpiRes, pg8::StaticOrder, true, true, 2048, 2048>((LAS unsigned char*)lds, g, S, E, wave);
#endif
    }
#undef IN
#undef SEAM
#undef lane
}

#ifndef ONE_LAUNCH
#define ONE_LAUNCH 1
#endif
extern "C" void kernel_launch(void* const* d_in, const int* in_sizes, int n_in, void* d_out, int out_size, void* d_ws, size_t ws_size, hipStream_t stream) {
    static int grid = 0;
    if (grid == 0) {
        if (n_in != 17 || in_sizes[0] != NTOK * DM || out_size != NTOK * DM || ws_size < WS_END) {
            fprintf(stderr, "kernel_launch: unexpected shapes (n_in %d, in0 %d, out %d, ws %zu < %zu)\n", n_in, n_in > 0 ? in_sizes[0] : -1, out_size, ws_size, (size_t)WS_END); grid = -1; return; }
        int dev = 0, cus = 0, per_cu = 0;
        (void)hipGetDevice(&dev); (void)hipDeviceGetAttribute(&cus, hipDeviceAttributeMultiprocessorCount, dev);
        if (hipFuncSetAttribute((const void*)yoco_fwd, hipFuncAttributeMaxDynamicSharedMemorySize, LDS_BYTES) != hipSuccess) { fprintf(stderr, "kernel_launch: hipFuncSetAttribute failed\n"); grid = -1; return; }
        (void)hipOccupancyMaxActiveBlocksPerMultiprocessor(&per_cu, (const void*)yoco_fwd, 512, LDS_BYTES);
        (void)hipGetLastError();
        if (per_cu < 1) per_cu = 1;
        grid = cus > 0 ? cus : 256;
    }
    if (grid < 0) return;
    Args a{};
    for (int i = 0; i < 17; ++i) a.in[i] = (const float*)d_in[i];
    a.out = (float*)d_out; a.ws = (unsigned char*)d_ws;
#if ONE_LAUNCH
    a.ph_lo = 0; a.ph_hi = NPHASE;
    void* kargs[] = {&a};
    hipError_t e = hipLaunchCooperativeKernel((const void*)yoco_fwd, dim3(grid), dim3(512), kargs, LDS_BYTES, stream);
    if (e != hipSuccess) fprintf(stderr, "cooperative launch failed: %s (grid %d)\n", hipGetErrorString(e), grid);
#else
    for (int ph = 0; ph < NPHASE; ++ph) { a.ph_lo = ph; a.ph_hi = ph + 1;
        hipLaunchKernelGGL(yoco_fwd, dim3(grid), dim3(512), LDS_BYTES, stream, a); }
#endif
}
```

```cpp
#include <hip/hip_runtime.h>
#include <hip/hip_cooperative_groups.h>
#include <cstdio>
#include <cstdint>
namespace cg = cooperative_groups;
__device__ __forceinline__ int lane_id() { return (int)__builtin_amdgcn_mbcnt_hi(~0u, __builtin_amdgcn_mbcnt_lo(~0u, 0u)); }
namespace pg8 {
#define PG8_LAS __attribute__((address_space(3)))
typedef unsigned short bf16_t;
typedef short bf16x8 __attribute__((ext_vector_type(8)));
typedef float f32x4 __attribute__((ext_vector_type(4)));
typedef unsigned u32x4 __attribute__((ext_vector_type(4)));
constexpr int BM = 256, BK = 64, HALF = 128, HTB = HALF * BK * 2  , STAGE_BYTES = 8 * HTB, NXCD = 8, WGM = 4;

__host__ __device__ __forceinline__ int lds_byte(int r, int c) { const int st = (r >> 4) * 2 + (c >> 5), rr = r & 15, cc = c & 31, ob = rr * 64 + cc * 2; return st * 1024 + (ob ^ (((ob >> 9) & 1) << 5)); }
__host__ __device__ __forceinline__ void stage_rc(int b, int& R, int& C) { const int st = b / 1024, sb = b % 1024, swz = sb ^ (((sb >> 9) & 1) << 5); R = (st >> 1) * 16 + swz / 64; C = (st & 1) * 32 + (swz % 64) / 2; }
__host__ __device__ __forceinline__ int perm32(int rho) { const int n = rho >> 4, i = rho & 15; return 8 * (i >> 2) + 4 * n + (i & 3); }

struct Unit { int pm, pn; };
struct Gemm { const bf16_t* A; const bf16_t* Bt; int M, N, K, lda; };

struct StaticOrder {
    int nM, nN, nwg, G, c;
    __host__ __device__ void init(int M, int N, int G_, int c_) { nM = M / BM; nN = N / BM; nwg = nM * nN; G = G_; c = c_; }
    __host__ __device__ bool next(int i, Unit& u) const {
        const long L = (long)i * G + c; if (L >= nwg) return false;
        int wgid = (int)L; { const int q = nwg / NXCD, r = nwg % NXCD, xcd = wgid % NXCD, off = wgid / NXCD; wgid = (xcd < r ? xcd * (q + 1) : r * (q + 1) + (xcd - r) * q) + off; }
        const int nig = WGM * nN, gid = wgid / nig, fm = gid * WGM, gsz = (nM - fm) < WGM ? (nM - fm) : WGM;
        u.pm = fm + ((wgid % nig) % gsz); u.pn = (wgid % nig) / gsz; return true;
    }
    __device__ __forceinline__ void a_ready(const Unit&) const {}
    __device__ __forceinline__ void done(const Unit&) const {}
};

__device__ __forceinline__ unsigned cvt_pk_bf16(float lo, float hi) { unsigned r; asm volatile("v_cvt_pk_bf16_f32 %0, %1, %2" : "=v"(r) : "v"(lo), "v"(hi)); return r; }
template <class Epi, class Sched, bool ALIGN_EPI, bool SP2, int KC, int LDAC>
__device__ __forceinline__ void gemm_phase(PG8_LAS unsigned char* lds, const Gemm g, const Sched& S, const Epi& E, int wid_in) {
    const int wid = __builtin_amdgcn_readfirstlane(wid_in), lane = lane_id(), tid = wid * 64 + lane, wr = wid >> 2, wc = wid & 3, fr = lane & 15, fq = lane >> 4;
    constexpr int K = KC, nt = K / BK, lda = LDAC;
    unsigned voffA[2], voffB[2];
#pragma unroll
    for (int i = 0; i < 2; ++i) { int R, C; stage_rc(tid * 16 + i * 8192, R, C); const int Rb = Epi::PERM ? ((R & ~31) + perm32(R & 31)) : R;
        voffA[i] = (unsigned)(R * lda + C) * 2u; voffB[i] = (unsigned)(Rb * K + C) * 2u; }
    const size_t kstep = (size_t)(BK * 2);
    const size_t hstep = (size_t)HALF * K * 2;
    const size_t tstep = 2 * hstep; const size_t hstepA = (size_t)HALF * lda * 2, tstepA = 2 * hstepA;
    const unsigned ldsw = (unsigned)wid * 1024u;
    const int aoff = lds_byte(wr * 64 + fr, fq * 8), boff = lds_byte(wc * 32 + fr, fq * 8);
#define PG8_SA(b, h) (((b) * 2 + (h)) * HTB)
#define PG8_SB(b, h) ((4 + (b) * 2 + (h)) * HTB)
#define PG8_STAGE(bufoff, gbase, voff) do { _Pragma("unroll") for (int _i = 0; _i < 2; ++_i) \
        __builtin_amdgcn_global_load_lds((const unsigned*)((const char*)(gbase) + (voff)[_i]), (PG8_LAS unsigned*)(lds + (bufoff) + ldsw + _i * 8192), 16, 0, 0); } while (0)
#define PG8_LDA(dst, b, h) do { _Pragma("unroll") for (int m = 0; m < 4; ++m) _Pragma("unroll") for (int k = 0; k < 2; ++k) dst[m][k] = *(const PG8_LAS bf16x8*)(lds + PG8_SA(b, h) + aoff + m * 2048 + k * 1024); } while (0)
#define PG8_LDB(dst, b, h) do { _Pragma("unroll") for (int n = 0; n < 2; ++n) _Pragma("unroll") for (int k = 0; k < 2; ++k) dst[n][k] = *(const PG8_LAS bf16x8*)(lds + PG8_SB(b, h) + boff + n * 2048 + k * 1024); } while (0)
#define PG8_MMA(ai, bj, At, Bt) do { __builtin_amdgcn_s_setprio(1); _Pragma("unroll") for (int m = 0; m < 4; ++m) _Pragma("unroll") for (int n = 0; n < 2; ++n) _Pragma("unroll") for (int k = 0; k < 2; ++k) \
        acc[ai][bj][m][n] = __builtin_amdgcn_mfma_f32_16x16x32_bf16(Bt[n][k], At[m][k], acc[ai][bj][m][n], 0, 0, 0); __builtin_amdgcn_s_setprio(0); } while (0)
#define PG8_WAIT_V(n) asm volatile("s_waitcnt vmcnt(" #n ")" ::: "memory")
#define PG8_WAIT_L(n) asm volatile("s_waitcnt lgkmcnt(" #n ")" ::: "memory")
#define PG8_BAR __builtin_amdgcn_s_barrier()
#define PG8_SCHED __builtin_amdgcn_sched_barrier(0)
    Unit cur, nxt; int ui = 0;
    if (!S.next(0, cur)) return;
    f32x4 acc[2][2][4][2];
#pragma unroll
    for (int a = 0; a < 2; ++a)
#pragma unroll
        for (int b = 0; b < 2; ++b)
#pragma unroll
            for (int m = 0; m < 4; ++m)
#pragma unroll
                for (int n = 0; n < 2; ++n) acc[a][b][m][n] = (f32x4){0.f, 0.f, 0.f, 0.f};
    bf16x8 At[4][2], B0[2][2], B1[2][2];
    const char* cA = (const char*)g.A + (size_t)cur.pm * tstepA; const char* cB = (const char*)g.Bt + (size_t)cur.pn * tstep;
    S.a_ready(cur);
    if constexpr (SP2) {
        PG8_STAGE(PG8_SB(0, 0), cB, voffB); PG8_STAGE(PG8_SB(0, 1), cB + hstep, voffB); PG8_STAGE(PG8_SA(0, 0), cA, voffA); PG8_STAGE(PG8_SA(0, 1), cA + hstepA, voffA);
        if (wr == 1) PG8_BAR;
        PG8_WAIT_V(2); PG8_BAR;
        PG8_STAGE(PG8_SB(1, 0), cB + kstep, voffB); PG8_STAGE(PG8_SA(1, 0), cA + kstep, voffA); PG8_STAGE(PG8_SB(1, 1), cB + hstep + kstep, voffB);
        PG8_WAIT_V(6); PG8_BAR;
    } else {
        PG8_STAGE(PG8_SB(0, 0), cB, voffB); PG8_STAGE(PG8_SA(0, 0), cA, voffA); PG8_STAGE(PG8_SB(0, 1), cB + hstep, voffB); PG8_STAGE(PG8_SA(0, 1), cA + hstepA, voffA);
        if (wr == 1) PG8_BAR;
        PG8_WAIT_V(4); PG8_BAR;
        PG8_STAGE(PG8_SB(1, 0), cB + kstep, voffB); PG8_STAGE(PG8_SA(1, 0), cA + kstep, voffA); PG8_STAGE(PG8_SB(1, 1), cB + hstep + kstep, voffB);
        PG8_WAIT_V(6); PG8_BAR;
    }
    for (;;) {
        const bool has_next = S.next(ui + 1, nxt);
        const char* nA = has_next ? (const char*)g.A + (size_t)nxt.pm * tstepA : cA; const char* nB = has_next ? (const char*)g.Bt + (size_t)nxt.pn * tstep : cB;
        for (int t = 0; t < nt; t += 2) {
            const bool last = (t == nt - 2);
            const char* a1 = cA + (size_t)(t + 1) * kstep;
            const char* a2 = last ? nA : cA + (size_t)(t + 2) * kstep; const char* b2 = last ? nB : cB + (size_t)(t + 2) * kstep;
            const char* a3 = a2 + kstep; const char* b3 = b2 + kstep;
            if (last && has_next) S.a_ready(nxt);
            if constexpr (SP2) {
            PG8_LDB(B0, 0, 0); PG8_LDB(B1, 0, 1); PG8_SCHED; PG8_LDA(At, 0, 0); PG8_STAGE(PG8_SA(1, 1), a1 + hstepA, voffA);
            PG8_WAIT_V(8); PG8_WAIT_L(0); PG8_BAR; PG8_MMA(0, 0, At, B0); PG8_MMA(0, 1, At, B1); PG8_BAR; PG8_SCHED;
            PG8_LDA(At, 0, 1); PG8_STAGE(PG8_SB(0, 0), b2, voffB); PG8_STAGE(PG8_SB(0, 1), b2 + hstep, voffB); PG8_STAGE(PG8_SA(0, 0), a2, voffA);
            PG8_WAIT_V(8); PG8_WAIT_L(0); PG8_BAR; PG8_MMA(1, 0, At, B0); PG8_MMA(1, 1, At, B1); PG8_BAR; PG8_SCHED;
            PG8_LDB(B0, 1, 0); PG8_LDB(B1, 1, 1); PG8_SCHED; PG8_LDA(At, 1, 0); PG8_STAGE(PG8_SA(0, 1), a2 + hstepA, voffA);
            PG8_WAIT_V(8); PG8_WAIT_L(0); PG8_BAR; PG8_MMA(0, 0, At, B0); PG8_MMA(0, 1, At, B1); PG8_BAR; PG8_SCHED;
            PG8_LDA(At, 1, 1); PG8_STAGE(PG8_SB(1, 0), b3, voffB); PG8_STAGE(PG8_SB(1, 1), b3 + hstep, voffB); PG8_STAGE(PG8_SA(1, 0), a3, voffA);
            PG8_WAIT_V(8); PG8_WAIT_L(0); PG8_BAR; PG8_MMA(1, 0, At, B0); PG8_MMA(1, 1, At, B1); PG8_BAR; PG8_SCHED;
            } else {
            PG8_LDB(B0, 0, 0); PG8_SCHED; PG8_LDA(At, 0, 0); PG8_STAGE(PG8_SA(1, 1), a1 + hstepA, voffA);
            PG8_WAIT_L(8); PG8_BAR; PG8_WAIT_L(0); PG8_MMA(0, 0, At, B0); PG8_BAR; PG8_SCHED;
            PG8_LDB(B1, 0, 1); PG8_STAGE(PG8_SB(0, 0), b2, voffB);
            PG8_BAR; PG8_WAIT_L(0); PG8_MMA(0, 1, At, B1); PG8_BAR;
            PG8_LDA(At, 0, 1); PG8_STAGE(PG8_SA(0, 0), a2, voffA);
            PG8_BAR; PG8_WAIT_L(0); PG8_MMA(1, 0, At, B0); PG8_BAR; PG8_SCHED;
            PG8_STAGE(PG8_SB(0, 1), b2 + hstep, voffB);
            PG8_WAIT_V(6); PG8_BAR; PG8_MMA(1, 1, At, B1); PG8_BAR;
            PG8_LDB(B0, 1, 0); PG8_SCHED; PG8_LDA(At, 1, 0); PG8_STAGE(PG8_SA(0, 1), a2 + hstepA, voffA);
            PG8_WAIT_L(8); PG8_BAR; PG8_WAIT_L(0); PG8_MMA(0, 0, At, B0); PG8_BAR; PG8_SCHED;
            PG8_LDB(B1, 1, 1); PG8_STAGE(PG8_SB(1, 0), b3, voffB);
            PG8_BAR; PG8_WAIT_L(0); PG8_MMA(0, 1, At, B1); PG8_BAR;
            PG8_LDA(At, 1, 1); PG8_STAGE(PG8_SA(1, 0), a3, voffA);
            PG8_BAR; PG8_WAIT_L(0); PG8_MMA(1, 0, At, B0); PG8_BAR; PG8_SCHED;
            PG8_STAGE(PG8_SB(1, 1), b3 + hstep, voffB);
            PG8_WAIT_V(6); PG8_BAR; PG8_MMA(1, 1, At, B1); PG8_BAR;
            }
        }
        if constexpr (ALIGN_EPI) { if (wr == 0) PG8_BAR; }
        if constexpr (!Epi::AFTER_DRAIN) { E(acc, cur, wr, wc, fr, fq); S.done(cur); }
        if (!has_next) break;
#pragma unroll
        for (int a = 0; a < 2; ++a)
#pragma unroll
            for (int b = 0; b < 2; ++b)
#pragma unroll
                for (int m = 0; m < 4; ++m)
#pragma unroll
                    for (int n = 0; n < 2; ++n) acc[a][b][m][n] = (f32x4){0.f, 0.f, 0.f, 0.f};
        cur = nxt; cA = nA; cB = nB; ++ui;
        if constexpr (ALIGN_EPI) { if (wr == 1) PG8_BAR; }
    }
    PG8_WAIT_V(0);
    if constexpr (!ALIGN_EPI) { if (wr == 0) PG8_BAR; }
    PG8_BAR;
    if constexpr (Epi::AFTER_DRAIN) { E.fused(acc, cur, wr, wc, fr, fq, lds, wid, lane); S.done(cur); }
#undef PG8_SA
#undef PG8_SB
#undef PG8_STAGE
#undef PG8_LDA
#undef PG8_LDB
#undef PG8_MMA
#undef PG8_WAIT_V
#undef PG8_WAIT_L
#undef PG8_BAR
#undef PG8_SCHED
}
}

namespace pg8 {
struct EpiSt {
    static constexpr bool PERM = true, AFTER_DRAIN = false;
    bf16_t* O; int ldc; int ncut; bf16_t* O2; int ldc2; int col2;
    __device__ __forceinline__ void operator()(const f32x4 (&acc)[2][2][4][2], const Unit& u, int wr, int wc, int fr, int fq) const {
        const int row0 = u.pm * BM + wr * 64 + fr;
        bf16_t* base = O; int ld = ldc; int colt = u.pn * BM;
        if (u.pn >= ncut) { base = O2; ld = ldc2; colt = col2 + (u.pn - ncut) * BM; }
        const int col0 = colt + wc * 32 + 8 * fq;
#pragma unroll
        for (int ai = 0; ai < 2; ++ai)
#pragma unroll
            for (int m = 0; m < 4; ++m) { bf16_t* rowp = base + (size_t)(row0 + ai * HALF + m * 16) * ld + col0;
#pragma unroll
                for (int bj = 0; bj < 2; ++bj) { const f32x4 v0 = acc[ai][bj][m][0], v1 = acc[ai][bj][m][1];
                    u32x4 w; w.x = cvt_pk_bf16(v0[0], v0[1]); w.y = cvt_pk_bf16(v0[2], v0[3]); w.z = cvt_pk_bf16(v1[0], v1[1]); w.w = cvt_pk_bf16(v1[2], v1[3]);
                    *(u32x4*)(rowp + bj * HALF) = w; } }
    }
};
struct EpiStNorm {
    static constexpr bool PERM = true, AFTER_DRAIN = false;
    bf16_t* O; int ldc; int ncut; bf16_t* O2; int ldc2; int col2; const float* gq; const float* gk; PG8_LAS float* P; float qscale, eps;
    __device__ __forceinline__ void operator()(const f32x4 (&acc)[2][2][4][2], const Unit& u, int wr, int wc, int fr, int fq) const {
        const int row0 = u.pm * BM + wr * 64 + fr;
        const bool gate = u.pn >= ncut;
        bf16_t* base = O; int ld = ldc; int colt = u.pn * BM;
        if (gate) { base = O2; ld = ldc2; colt = col2 + (u.pn - ncut) * BM; }
        const int col0 = colt + wc * 32 + 8 * fq;
        int part[2], br[2];
#pragma unroll
        for (int bj = 0; bj < 2; ++bj) { const int rem = (u.pn * 2 + bj) % 9; part[bj] = gate ? 2 : rem / 3; br[bj] = rem % 3; }
        f32x4 cg[2][2];
#pragma unroll
        for (int bj = 0; bj < 2; ++bj) {
            cg[bj][0] = (f32x4){1.f, 1.f, 1.f, 1.f}; cg[bj][1] = cg[bj][0];
            if (part[bj] == 0) { const int e = br[bj] * 128 + wc * 32 + 8 * fq;
                cg[bj][0] = *(const f32x4*)(gq + e) * *(const f32x4*)(gk + e) * qscale; cg[bj][1] = *(const f32x4*)(gq + e + 4) * *(const f32x4*)(gk + e + 4) * qscale; } }
        float sc[2][2][4];
#pragma unroll
        for (int ai = 0; ai < 2; ++ai)
#pragma unroll
            for (int bj = 0; bj < 2; ++bj)
#pragma unroll
                for (int m = 0; m < 4; ++m) sc[ai][bj][m] = 1.f;
        if (part[0] < 2 || part[1] < 2) {
#pragma unroll
            for (int ai = 0; ai < 2; ++ai)
#pragma unroll
                for (int bj = 0; bj < 2; ++bj)
#pragma unroll
                    for (int m = 0; m < 4; ++m) if (part[bj] < 2) { const f32x4 a = acc[ai][bj][m][0], b = acc[ai][bj][m][1];
                        float q = (a[0] * a[0] + a[1] * a[1]) + (a[2] * a[2] + a[3] * a[3]) + (b[0] * b[0] + b[1] * b[1]) + (b[2] * b[2] + b[3] * b[3]);
                        { auto rr = __builtin_amdgcn_permlane16_swap(__float_as_uint(q), __float_as_uint(q), false, false); q = __uint_as_float(rr[0]) + __uint_as_float(rr[1]); }
                        { auto rr = __builtin_amdgcn_permlane32_swap(__float_as_uint(q), __float_as_uint(q), false, false); q = __uint_as_float(rr[0]) + __uint_as_float(rr[1]); }
                        if (fq == 0) P[(bj * 256 + ai * HALF + wr * 64 + m * 16 + fr) * 4 + wc] = q; }
            asm volatile("s_waitcnt lgkmcnt(0)\n\ts_barrier" ::: "memory");
#pragma unroll
            for (int ai = 0; ai < 2; ++ai)
#pragma unroll
                for (int bj = 0; bj < 2; ++bj)
#pragma unroll
                    for (int m = 0; m < 4; ++m) if (part[bj] < 2) { const f32x4 t = *(const PG8_LAS f32x4*)(P + (bj * 256 + ai * HALF + wr * 64 + m * 16 + fr) * 4);
                        sc[ai][bj][m] = __builtin_amdgcn_rsqf(((t[0] + t[1]) + (t[2] + t[3])) * (1.0f / 128.0f) + eps); }
        }
#pragma unroll
        for (int ai = 0; ai < 2; ++ai)
#pragma unroll
            for (int m = 0; m < 4; ++m) { bf16_t* rowp = base + (size_t)(row0 + ai * HALF + m * 16) * ld + col0;
#pragma unroll
                for (int bj = 0; bj < 2; ++bj) { const f32x4 v0 = acc[ai][bj][m][0] * cg[bj][0] * sc[ai][bj][m], v1 = acc[ai][bj][m][1] * cg[bj][1] * sc[ai][bj][m];
                    u32x4 w; w.x = cvt_pk_bf16(v0[0], v0[1]); w.y = cvt_pk_bf16(v0[2], v0[3]); w.z = cvt_pk_bf16(v1[0], v1[1]); w.w = cvt_pk_bf16(v1[2], v1[3]);
                    *(u32x4*)(rowp + bj * HALF) = w; } }
    }
};
struct EpiRes {
    static constexpr bool PERM = false, AFTER_DRAIN = false;
    const float* base; float* out; int ldc; bool nt_ld, nt_st;
    __device__ __forceinline__ void operator()(const f32x4 (&acc)[2][2][4][2], const Unit& u, int wr, int wc, int fr, int fq) const {
        const int col0 = u.pn * BM + wc * 32 + 4 * fq;
#pragma unroll
        for (int ai = 0; ai < 2; ++ai) {
            const size_t off0 = (size_t)(u.pm * BM + ai * HALF + wr * 64 + fr) * ldc + col0;
            f32x4 bs[4][2][2];
#pragma unroll
            for (int m = 0; m < 4; ++m)
#pragma unroll
                for (int bj = 0; bj < 2; ++bj)
#pragma unroll
                    for (int n = 0; n < 2; ++n) { const f32x4* p_ = (const f32x4*)(base + off0 + (size_t)m * 16 * ldc + bj * HALF + n * 16); bs[m][bj][n] = nt_ld ? __builtin_nontemporal_load(p_) : *p_; }
            asm volatile("" ::: "memory");
#pragma unroll
            for (int m = 0; m < 4; ++m)
#pragma unroll
                for (int bj = 0; bj < 2; ++bj)
#pragma unroll
                    for (int n = 0; n < 2; ++n) { f32x4* q_ = (f32x4*)(out + off0 + (size_t)m * 16 * ldc + bj * HALF + n * 16); const f32x4 r_ = bs[m][bj][n] + acc[ai][bj][m][n]; if (nt_st) __builtin_nontemporal_store(r_, q_); else *q_ = r_; }
            asm volatile("" ::: "memory");
        }
    }
};
}

constexpr int SEQ = 16384, NTOK = 32768, DM = 2048;
constexpr int UCOLS = 3328;
constexpr int QCOLS = 3072, KVCOLS = 4096, KRCOLS = 1024;
constexpr int GCOLS = 4608, GN = 5120;
constexpr float EPSN = 1e-6f;
constexpr float LOG2E = 1.4426950408889634f;
constexpr float QSCALE_A = 0.10411754627697264f;
constexpr float QSCALE_B = 0.12751743082459868f;
constexpr size_t MiB = 1u << 20;
constexpr size_t WS_WAIN = 0, WS_WQUP = 14 * MiB, WS_WKVUP = 17 * MiB, WS_WAO = 21 * MiB, WS_WBALL = 29 * MiB, WS_WBO = 109 * MiB;
constexpr size_t WS_LSE = 120 * MiB, WS_ROPE = 122 * MiB;
constexpr size_t WS_XN = 144 * MiB;
constexpr size_t WS_U = 272 * MiB, WS_Q = 480 * MiB, WS_KV = 672 * MiB, WS_KR = 928 * MiB;
constexpr size_t WS_G = 272 * MiB, WS_GATE = 560 * MiB, WS_OP = 688 * MiB, WS_OG = 784 * MiB;
constexpr size_t WS_END = 992 * MiB;
constexpr int LDS_BYTES = 147456;
constexpr int NPHASE = 20;
constexpr int DUP = 0;

typedef unsigned short bf16;
typedef short bf16x8 __attribute__((ext_vector_type(8)));
typedef short s16x4 __attribute__((ext_vector_type(4)));
typedef float f32x16 __attribute__((ext_vector_type(16)));
typedef float f32x4 __attribute__((ext_vector_type(4)));
typedef unsigned u32x4 __attribute__((ext_vector_type(4)));
typedef unsigned u32x2 __attribute__((ext_vector_type(2)));
#define LAS __attribute__((address_space(3)))

struct Args { const float* in[17]; float* out; unsigned char* ws; int ph_lo, ph_hi; };

__device__ __forceinline__ float bf2f(unsigned short h) { return __uint_as_float((unsigned)h << 16); }
__device__ __forceinline__ float bflo(unsigned w) { return __uint_as_float(w << 16); }
__device__ __forceinline__ float bfhi(unsigned w) { return __uint_as_float(w & 0xffff0000u); }
__device__ __forceinline__ unsigned cvtpk(float lo, float hi) { unsigned r; asm volatile("v_cvt_pk_bf16_f32 %0, %1, %2" : "=v"(r) : "v"(lo), "v"(hi)); return r; }
__device__ __forceinline__ unsigned short f2bf(float f) { return (unsigned short)(cvtpk(f, 0.f) & 0xffffu); }
__device__ __forceinline__ float wave_sum(float v) {
#pragma unroll
    for (int o = 1; o < 64; o <<= 1) v += __shfl_xor(v, o);
    return v;
}
__device__ __forceinline__ float silu_f(float g) { return g * __builtin_amdgcn_rcpf(1.f + __builtin_amdgcn_exp2f(g * -1.4426950408889634f)); }

__device__ __forceinline__ int dst_row(int map, int n0) {
    if (map == 0) return n0;
    if (map == 1) { const int part2 = n0 / 6144, r = n0 % 6144, br = r / 2048, h = (r % 2048) / 128, e = r % 128;
        return (h >> 2) * GN + (h & 3) * 1152 + (1 + part2) * 384 + br * 128 + e; }
    if (n0 < 6144) { const int br = n0 / 2048, h = (n0 % 2048) / 128, e = n0 % 128; return (h >> 2) * GN + (h & 3) * 1152 + br * 128 + e; }
    { const int c = n0 - 6144, h = c / 128, e = c % 128; return (h >> 2) * GN + GCOLS + (h & 3) * 128 + e; }
}
__device__ __forceinline__ void transpose_item(const float* W, int K, int N, const float* gain, bf16* WT, int map, LAS float* scr, int item, int lane) {
    const int nblk = N / 32, kb = item / nblk, nb = item % nblk, k0 = 64 * kb, n0 = 32 * nb;
    float wv[32];
#pragma unroll
    for (int i = 0; i < 32; ++i) wv[i] = __builtin_nontemporal_load(W + (size_t)(k0 + 2 * i + (lane >> 5)) * N + n0 + (lane & 31));
#pragma unroll
    for (int i = 0; i < 32; ++i) { const int kk = 2 * i + (lane >> 5); const float gsc = gain ? gain[k0 + kk] : 1.f;
        scr[kk * 33 + (lane & 31)] = wv[i] * gsc; }
    asm volatile("s_waitcnt lgkmcnt(0)" ::: "memory");
    const int c = lane & 7; const int d0 = dst_row(map, n0);
#pragma unroll
    for (int j = 0; j < 4; ++j) { const int n = (lane >> 3) + 8 * j; const LAS float* s = scr + (8 * c) * 33 + n;
        u32x4 o; o.x = cvtpk(s[0 * 33], s[1 * 33]); o.y = cvtpk(s[2 * 33], s[3 * 33]); o.z = cvtpk(s[4 * 33], s[5 * 33]); o.w = cvtpk(s[6 * 33], s[7 * 33]);
        *(u32x4*)(WT + (size_t)(d0 + n) * K + k0 + 8 * c) = o; }
    asm volatile("s_waitcnt lgkmcnt(0)" ::: "memory");
}
__device__ __forceinline__ void norm_row(const float* xrow, bf16* orow, int lane) {
    const f32x4* xr = (const f32x4*)xrow + lane;
    f32x4 v[8]; float s = 0.f;
#pragma unroll
    for (int j = 0; j < 8; ++j) { v[j] = xr[64 * j]; s += (v[j].x * v[j].x + v[j].y * v[j].y) + (v[j].z * v[j].z + v[j].w * v[j].w); }
    const float rstd = __builtin_amdgcn_rsqf(wave_sum(s) * (1.f / DM) + EPSN);
    u32x2* o8 = (u32x2*)orow + lane;
#pragma unroll
    for (int j = 0; j < 8; ++j) { u32x2 w; w.x = cvtpk(v[j].x * rstd, v[j].y * rstd); w.y = cvtpk(v[j].z * rstd, v[j].w * rstd); o8[64 * j] = w; }
}

template <bool NT_> __device__ __forceinline__ void norm_row2(const float* xa, bf16* oa, const float* xb, bf16* ob, int lane) {
    const f32x4* ra = (const f32x4*)xa + lane; const f32x4* rb = (const f32x4*)xb + lane;
    f32x4 va[8], vb[8]; float sa = 0.f, sb = 0.f;
#pragma unroll
    for (int j = 0; j < 8; ++j) { if (NT_) { va[j] = __builtin_nontemporal_load(ra + 64 * j); vb[j] = __builtin_nontemporal_load(rb + 64 * j); } else { va[j] = ra[64 * j]; vb[j] = rb[64 * j]; } }
#pragma unroll
    for (int j = 0; j < 8; ++j) { sa += (va[j].x * va[j].x + va[j].y * va[j].y) + (va[j].z * va[j].z + va[j].w * va[j].w);
                                  sb += (vb[j].x * vb[j].x + vb[j].y * vb[j].y) + (vb[j].z * vb[j].z + vb[j].w * vb[j].w); }
    const float rsa = __builtin_amdgcn_rsqf(wave_sum(sa) * (1.f / DM) + EPSN), rsb = __builtin_amdgcn_rsqf(wave_sum(sb) * (1.f / DM) + EPSN);
    u32x2* pa = (u32x2*)oa + lane; u32x2* pb = (u32x2*)ob + lane;
#pragma unroll
    for (int j = 0; j < 8; ++j) { u32x2 w; w.x = cvtpk(va[j].x * rsa, va[j].y * rsa); w.y = cvtpk(va[j].z * rsa, va[j].w * rsa); pa[64 * j] = w;
                                  u32x2 z; z.x = cvtpk(vb[j].x * rsb, vb[j].y * rsb); z.y = cvtpk(vb[j].z * rsb, vb[j].w * rsb); pb[64 * j] = z; }
}

__device__ __forceinline__ void norm_row4_nt(const float* x0, bf16* o0, size_t rstride, int lane) {
    f32x4 v[4][8]; float s[4] = {0.f, 0.f, 0.f, 0.f};
#pragma unroll
    for (int k = 0; k < 4; ++k) { const f32x4* r = (const f32x4*)(x0 + k * rstride) + lane;
#pragma unroll
        for (int j = 0; j < 8; ++j) v[k][j] = __builtin_nontemporal_load(r + 64 * j); }
#pragma unroll
    for (int k = 0; k < 4; ++k)
#pragma unroll
        for (int j = 0; j < 8; ++j) s[k] += (v[k][j].x * v[k][j].x + v[k][j].y * v[k][j].y) + (v[k][j].z * v[k][j].z + v[k][j].w * v[k][j].w);
#pragma unroll
    for (int k = 0; k < 4; ++k) { const float rs = __builtin_amdgcn_rsqf(wave_sum(s[k]) * (1.f / DM) + EPSN); u32x2* p = (u32x2*)(o0 + k * rstride) + lane;
#pragma unroll
        for (int j = 0; j < 8; ++j) { u32x2 w; w.x = cvtpk(v[k][j].x * rs, v[k][j].y * rs); w.y = cvtpk(v[k][j].z * rs, v[k][j].w * rs); p[64 * j] = w; } }
}

__device__ __forceinline__ void sincos_pos(int s, int i, float& c, float& sn) {
    double inv = 1.0;
    if (i & 1) inv *= 0.7498942093324559; if (i & 2) inv *= 0.5623413251903491; if (i & 4) inv *= 0.31622776601683794; if (i & 8) inv *= 0.1; if (i & 16) inv *= 0.01;
    const double a = (double)s * inv;
    const double k = __builtin_rint(a * 0.15915494309189535);
    double r = __builtin_fma(-k, 6.283185307179586, a); r = __builtin_fma(-k, 2.4492935982947064e-16, r);
    const double r2 = r * r;
    double ps = -3.868170170630684e-23; ps = ps * r2 + 1.9572941063391263e-20; ps = ps * r2 - 8.22063524662433e-18; ps = ps * r2 + 2.8114572543455206e-15; ps = ps * r2 - 7.647163731819816e-13;
    ps = ps * r2 + 1.6059043836821613e-10; ps = ps * r2 - 2.505210838544172e-08; ps = ps * r2 + 2.7557319223985893e-06; ps = ps * r2 - 0.0001984126984126984; ps = ps * r2 + 0.008333333333333333;
    ps = ps * r2 - 0.16666666666666666; ps = ps * r2 + 1.0;
    double pc = -8.896791392450574e-22; pc = pc * r2 + 4.110317623312165e-19; pc = pc * r2 - 1.5619206968586225e-16; pc = pc * r2 + 4.779477332387385e-14; pc = pc * r2 - 1.1470745597729725e-11;
    pc = pc * r2 + 2.08767569878681e-09; pc = pc * r2 - 2.755731922398589e-07; pc = pc * r2 + 2.48015873015873e-05; pc = pc * r2 - 0.001388888888888889; pc = pc * r2 + 0.041666666666666664;
    pc = pc * r2 - 0.5; pc = pc * r2 + 1.0;
    sn = (float)(ps * r); c = (float)pc;
}
__device__ __forceinline__ void unpack8(const u32x4 a, float* f) {
#pragma unroll
    for (int j = 0; j < 4; ++j) { f[2 * j] = bflo(a[j]); f[2 * j + 1] = bfhi(a[j]); }
}
__device__ __forceinline__ u32x4 pack8f(const float* f) { u32x4 w; w.x = cvtpk(f[0], f[1]); w.y = cvtpk(f[2], f[3]); w.z = cvtpk(f[4], f[5]); w.w = cvtpk(f[6], f[7]); return w; }
__device__ __forceinline__ void qknorm_phase(unsigned char* ws, const float* gq, const float* gk, int gw, int ngw, int lane) {
    bf16* U = (bf16*)(ws + WS_U); bf16* Q = (bf16*)(ws + WS_Q); bf16* KV = (bf16*)(ws + WS_KV);
    const float* COS = (const float*)(ws + WS_ROPE); const float* SIN = COS + SEQ * 32;
    const int h = lane >> 2, part = lane & 3;
    for (int t = gw; t < NTOK; t += ngw) {
        const int s = t & (SEQ - 1);
        const float* gqp = gq; const float* gkp = gk; asm volatile("" : "+s"(gqp), "+s"(gkp));
        char* ub = (char*)(U + (size_t)t * UCOLS); char* qb = (char*)(Q + (size_t)t * QCOLS); char* kb = (char*)(KV + (size_t)t * KVCOLS);
        const unsigned oq = (unsigned)(h * 192 + part * 32) * 2u, oq1 = (unsigned)(h * 192 + 128 + part * 8) * 2u, ok = (unsigned)(h * 256 + part * 64) * 2u;
        const unsigned opeo = (unsigned)(1024 + part * 8) * 2u, okr = (unsigned)(h * 64 + part * 8) * 2u;
        bf16* urow = (bf16*)ub; bf16* qp = (bf16*)qb + h * 192; bf16* kp = (bf16*)(kb + ok);
        const u32x4 cqv = *(const u32x4*)(ub + 16u * (unsigned)lane);
        u32x4 qn[4];
#pragma unroll
        for (int i = 0; i < 4; ++i) qn[i] = *(const u32x4*)(qb + oq + 16u * i);
        const u32x4 qr1 = *(const u32x4*)(qb + oq1), qr2 = *(const u32x4*)(qb + oq1 + 64u);
        float cs[8], sn[8];
        { const char* cb_ = (const char*)(COS + s * 32); const char* sb_ = (const char*)(SIN + s * 32); unsigned ot = (unsigned)part * 32u; asm volatile("" : "+v"(ot));
          const f32x4 a = *(const f32x4*)(cb_ + ot), b = *(const f32x4*)(cb_ + ot + 16u), c = *(const f32x4*)(sb_ + ot), d = *(const f32x4*)(sb_ + ot + 16u);
#pragma unroll
          for (int j = 0; j < 4; ++j) { cs[j] = a[j]; cs[4 + j] = b[j]; sn[j] = c[j]; sn[4 + j] = d[j]; } }
        float rstd_q;
        { float f[8]; unpack8(cqv, f); float q = 0.f;
#pragma unroll
          for (int j = 0; j < 8; ++j) q += f[j] * f[j];
          rstd_q = __builtin_amdgcn_rsqf(wave_sum(q) * (1.f / 512.f) + EPSN); }
        { float y[32], r1[8], r2[8]; float ssq = 0.f;
#pragma unroll
          for (int i = 0; i < 4; ++i) unpack8(qn[i], y + 8 * i);
          unpack8(qr1, r1); unpack8(qr2, r2);
#pragma unroll
          for (int j = 0; j < 32; ++j) ssq += y[j] * y[j];
#pragma unroll
          for (int j = 0; j < 8; ++j) ssq += r1[j] * r1[j] + r2[j] * r2[j];
          ssq += __shfl_xor(ssq, 1); ssq += __shfl_xor(ssq, 2);
          const float scq = rstd_q * (__builtin_amdgcn_rsqf(ssq * rstd_q * rstd_q * (1.f / 192.f) + EPSN)) * QSCALE_A;
#pragma unroll
          for (int i = 0; i < 8; ++i) { const f32x4 g = *(const f32x4*)(gqp + part * 32 + 4 * i);
#pragma unroll
              for (int j = 0; j < 4; ++j) y[4 * i + j] *= scq * g[j]; }
#pragma unroll
          for (int i = 0; i < 4; ++i) *(u32x4*)(qb + oq + 16u * i) = pack8f(y + 8 * i);
          float o1[8], o2[8];
#pragma unroll
          for (int i = 0; i < 2; ++i) { const f32x4 g1 = *(const f32x4*)(gqp + 128 + part * 8 + 4 * i), g2 = *(const f32x4*)(gqp + 160 + part * 8 + 4 * i);
#pragma unroll
              for (int j = 0; j < 4; ++j) { const int e = 4 * i + j; const float y1 = r1[e] * scq * g1[j], y2 = r2[e] * scq * g2[j];
                  o1[e] = y1 * cs[e] - y2 * sn[e]; o2[e] = y2 * cs[e] + y1 * sn[e]; } }
          *(u32x4*)(qb + oq1) = pack8f(o1); *(u32x4*)(qb + oq1 + 64u) = pack8f(o2); }
        __builtin_amdgcn_sched_barrier(0);
        const u32x4 ckvv = *(const u32x4*)(ub + 1024u + 16u * (unsigned)lane);
        const u32x4 pe1 = *(const u32x4*)(ub + opeo), pe2 = *(const u32x4*)(ub + opeo + 64u);
        u32x4 kvv[8];
#pragma unroll
        for (int i = 0; i < 8; ++i) kvv[i] = *(const u32x4*)(kb + ok + 16u * i);
        float rstd_kv, ssq_pe;
        { float f[8]; unpack8(ckvv, f); float q = 0.f;
#pragma unroll
          for (int j = 0; j < 8; ++j) q += f[j] * f[j];
          rstd_kv = __builtin_amdgcn_rsqf(wave_sum(q) * (1.f / 512.f) + EPSN); }
        float x1[8], x2[8]; unpack8(pe1, x1); unpack8(pe2, x2);
        { float q = 0.f;
#pragma unroll
          for (int j = 0; j < 8; ++j) q += x1[j] * x1[j] + x2[j] * x2[j];
          q += __shfl_xor(q, 1); q += __shfl_xor(q, 2); ssq_pe = q; }
        { float ssq = 0.f;
#pragma unroll
          for (int i = 0; i < 8; ++i) { float f[8]; unpack8(kvv[i], f);
#pragma unroll
              for (int j = 0; j < 8; ++j) ssq += f[j] * f[j]; }
          ssq = part < 2 ? ssq : 0.f;
          ssq += __shfl_xor(ssq, 1); ssq += __shfl_xor(ssq, 2);
          const float rk = __builtin_amdgcn_rsqf((ssq * rstd_kv * rstd_kv + ssq_pe) * (1.f / 192.f) + EPSN);
          const float sck = part < 2 ? rstd_kv * rk : rstd_kv;
#pragma unroll
          for (int i = 0; i < 8; ++i) { float f[8]; unpack8(kvv[i], f);
              f32x4 g0 = *(const f32x4*)(gkp + (part & 1) * 64 + 8 * i), g1 = *(const f32x4*)(gkp + (part & 1) * 64 + 8 * i + 4);
              if (part >= 2) { g0 = (f32x4){1.f, 1.f, 1.f, 1.f}; g1 = g0; }
#pragma unroll
              for (int j = 0; j < 4; ++j) { f[j] *= sck * g0[j]; f[4 + j] *= sck * g1[j]; }
              *(u32x4*)(kb + ok + 16u * i) = pack8f(f); }
          float o1[8], o2[8];
#pragma unroll
          for (int i = 0; i < 2; ++i) { const f32x4 g1 = *(const f32x4*)(gkp + 128 + part * 8 + 4 * i), g2 = *(const f32x4*)(gkp + 160 + part * 8 + 4 * i);
#pragma unroll
              for (int j = 0; j < 4; ++j) { const int e = 4 * i + j; const float y1 = x1[e] * rk * g1[j], y2 = x2[e] * rk * g2[j];
                  o1[e] = y1 * cs[e] - y2 * sn[e]; o2[e] = y2 * cs[e] + y1 * sn[e]; } }
          *(u32x4*)(ub + okr) = pack8f(o1); *(u32x4*)(ub + okr + 64u) = pack8f(o2); }
    }
}

#define SBAR() __builtin_amdgcn_sched_barrier(0)
__device__ __forceinline__ int v_st(int k, int c) { const int kk = (k & ~0xC) | ((k & 4) << 1) | ((k & 8) >> 1); return ((kk >> 3) * 4 + (c >> 5)) * 512 + ((kk & 7) * 32 + (c & 31)) * 2; }
__device__ __forceinline__ int v_rd_base(int lane) { return ((lane & 3) << 3) | (((lane >> 2) & 3) << 6) | (((lane >> 4) & 1) << 5) | (((lane >> 5) & 1) << 8); }
__device__ __forceinline__ int crow(int r, int hi) { return (r & 3) + 8 * (r >> 2) + 4 * hi; }
#define PK4(P, B_, OUT) do { unsigned a0 = cvtpk(P[B_+0], P[B_+1]), a1 = cvtpk(P[B_+2], P[B_+3]);                          \
        unsigned b0 = cvtpk(P[B_+4], P[B_+5]), b1 = cvtpk(P[B_+6], P[B_+7]);                                             \
        auto r0 = __builtin_amdgcn_permlane32_swap(a0, b0, false, false); auto r1 = __builtin_amdgcn_permlane32_swap(a1, b1, false, false); \
        u32x4 w = {r0[0], r1[0], r0[1], r1[1]}; OUT = *reinterpret_cast<bf16x8*>(&w); } while (0)
#define TRRD(dst, off) asm volatile("ds_read_b64_tr_b16 %0, %1 offset:%2" : "=&v"(dst) : "v"(vb0), "i"(off) : "memory")

namespace mla {
constexpr int SHM_V = 16384, SHM_K = 24576, OFF_K = 3 * SHM_V, OFF_WS = OFF_K + 3 * SHM_K;
__device__ __forceinline__ int kswz(int row, int colB) { return row * 384 + (colB ^ (((row >> 1) & 7) << 4)); }
#define MBAR() asm volatile("s_waitcnt lgkmcnt(0)\n\ts_barrier" ::: "memory")
__device__ __forceinline__ void qkt(f32x16& p0, f32x16& p1, const char* kbuf, const int* koff, const bf16x8* qr) {
    p0 = f32x16{}; p1 = f32x16{};
    int ka[4];
#pragma unroll
    for (int dd = 0; dd < 4; ++dd) ka[dd] = (int)(uintptr_t)kbuf + koff[dd];
    bf16x8 X0, X1, Y0, Y1, Z0, Z1;
#define KRD(S, s_) asm volatile("ds_read_b128 %0, %2 offset:%3\n\tds_read_b128 %1, %2 offset:%4" : "=&v"(S##0), "=&v"(S##1) : "v"(ka[(s_) & 3]), "i"(((s_) >> 2) * 128), "i"(((s_) >> 2) * 128 + 12288) : "memory")
#define KMM(S, s_) do { p0 = __builtin_amdgcn_mfma_f32_32x32x16_bf16(S##0, qr[s_], p0, 0, 0, 0); p1 = __builtin_amdgcn_mfma_f32_32x32x16_bf16(S##1, qr[s_], p1, 0, 0, 0); } while (0)
    KRD(X, 0); KRD(Y, 1);
    KRD(Z, 2); asm volatile("s_waitcnt lgkmcnt(4)" ::: "memory"); SBAR(); KMM(X, 0); SBAR();
    KRD(X, 3); asm volatile("s_waitcnt lgkmcnt(4)" ::: "memory"); SBAR(); KMM(Y, 1); SBAR();
    KRD(Y, 4); asm volatile("s_waitcnt lgkmcnt(4)" ::: "memory"); SBAR(); KMM(Z, 2); SBAR();
    KRD(Z, 5); asm volatile("s_waitcnt lgkmcnt(4)" ::: "memory"); SBAR(); KMM(X, 3); SBAR();
    KRD(X, 6); asm volatile("s_waitcnt lgkmcnt(4)" ::: "memory"); SBAR(); KMM(Y, 4); SBAR();
    KRD(Y, 7); asm volatile("s_waitcnt lgkmcnt(4)" ::: "memory"); SBAR(); KMM(Z, 5); SBAR();
    KRD(Z, 8); asm volatile("s_waitcnt lgkmcnt(4)" ::: "memory"); SBAR(); KMM(X, 6); SBAR();
    KRD(X, 9); asm volatile("s_waitcnt lgkmcnt(4)" ::: "memory"); SBAR(); KMM(Y, 7); SBAR();
    KRD(Y, 10); asm volatile("s_waitcnt lgkmcnt(4)" ::: "memory"); SBAR(); KMM(Z, 8); SBAR();
    KRD(Z, 11); asm volatile("s_waitcnt lgkmcnt(4)" ::: "memory"); SBAR(); KMM(X, 9); SBAR();
    asm volatile("s_waitcnt lgkmcnt(2)" ::: "memory"); SBAR(); KMM(Y, 10); SBAR();
    asm volatile("s_waitcnt lgkmcnt(0)" ::: "memory"); SBAR(); KMM(Z, 11); SBAR();
#undef KRD
#undef KMM
}
__device__ __forceinline__ void pv_tile(f32x16* o, int vb0, bf16x8 pa0, bf16x8 pa1, bf16x8 pa2, bf16x8 pa3) {
    s16x4 A0, A1, A2, A3, A4, A5, A6, A7, B0, B1, B2, B3, B4, B5, B6, B7;
#define RD8(S, d0) do { constexpr int b_ = (d0) * 512; TRRD(S##0, b_); TRRD(S##1, b_ + 2048); TRRD(S##2, b_ + 4096); TRRD(S##3, b_ + 6144); \
        TRRD(S##4, b_ + 8192); TRRD(S##5, b_ + 10240); TRRD(S##6, b_ + 12288); TRRD(S##7, b_ + 14336); } while (0)
#define MM4(S, d0) do { \
        o[d0] = __builtin_amdgcn_mfma_f32_32x32x16_bf16(pa0, (bf16x8){S##0[0], S##0[1], S##0[2], S##0[3], S##1[0], S##1[1], S##1[2], S##1[3]}, o[d0], 0, 0, 0); \
        o[d0] = __builtin_amdgcn_mfma_f32_32x32x16_bf16(pa1, (bf16x8){S##2[0], S##2[1], S##2[2], S##2[3], S##3[0], S##3[1], S##3[2], S##3[3]}, o[d0], 0, 0, 0); \
        o[d0] = __builtin_amdgcn_mfma_f32_32x32x16_bf16(pa2, (bf16x8){S##4[0], S##4[1], S##4[2], S##4[3], S##5[0], S##5[1], S##5[2], S##5[3]}, o[d0], 0, 0, 0); \
        o[d0] = __builtin_amdgcn_mfma_f32_32x32x16_bf16(pa3, (bf16x8){S##6[0], S##6[1], S##6[2], S##6[3], S##7[0], S##7[1], S##7[2], S##7[3]}, o[d0], 0, 0, 0); } while (0)
    RD8(A, 0);
    RD8(B, 1); asm volatile("s_waitcnt lgkmcnt(8)" ::: "memory"); SBAR(); MM4(A, 0); SBAR();
    RD8(A, 2); asm volatile("s_waitcnt lgkmcnt(8)" ::: "memory"); SBAR(); MM4(B, 1); SBAR();
    RD8(B, 3); asm volatile("s_waitcnt lgkmcnt(8)" ::: "memory"); SBAR(); MM4(A, 2); SBAR();
    asm volatile("s_waitcnt lgkmcnt(0)" ::: "memory"); SBAR(); MM4(B, 3);
#undef RD8
#undef MM4
}
__device__ __forceinline__ void block(int b, int h, int qb, unsigned char* ws, char* lds, int grp, int wid) {
    const bf16* Q = (const bf16*)(ws + WS_Q); const bf16* KV = (const bf16*)(ws + WS_KV); const bf16* KR = (const bf16*)(ws + WS_KR); const bf16* U = (const bf16*)(ws + WS_U); bf16* OG = (bf16*)(ws + WS_XN);
    const int lane = lane_id(), tid = wid * 64 + lane, r32 = lane & 31, hi = lane >> 5;
    const size_t tb = (size_t)b * SEQ;
    const int qlo = qb * 256 + wid * 32;
    char* V_lds = lds; char* K_lds = lds + OFF_K;
    float* wsf = (float*)(lds + OFF_WS) + wid * 64; float* li_l = wsf; float* al_l = wsf + 32;
    bf16x8 qr[12];
    { const bf16* qp = Q + (tb + qlo + r32) * QCOLS + h * 192 + hi * 8;
#pragma unroll
      for (int d0 = 0; d0 < 12; ++d0) qr[d0] = *(const bf16x8*)(qp + d0 * 16); }
    const int NT = (qb + 1) * 4;
    unsigned ko[3], ki[3], vo[2];
#pragma unroll
    for (int j = 0; j < 3; ++j) { const int pos = 1024 * (3 * wid + j) + 16 * lane, row = pos / 384, slot = (pos - row * 384) >> 4;
        const int ch = (slot & ~7) | ((slot & 7) ^ ((row >> 1) & 7));
        if (ch < 16) { ko[j] = (unsigned)WS_KV + (unsigned)((tb + row) * KVCOLS + h * 256 + ch * 8) * 2u; ki[j] = 64u * KVCOLS * 2u; }
        else { ko[j] = (unsigned)WS_U + (unsigned)((tb + row) * UCOLS + h * 64 + (ch - 16) * 8) * 2u; ki[j] = 64u * UCOLS * 2u; } }
#pragma unroll
    for (int j = 0; j < 2; ++j) { const int pos = 1024 * (2 * wid + j) + 16 * lane, st = pos >> 9, kk = (st >> 2) * 8 + ((pos & 511) >> 6), c = (st & 3) * 32 + ((pos & 63) >> 4) * 8;
        const int k = (kk & ~0xC) | ((kk & 4) << 1) | ((kk & 8) >> 1);
        vo[j] = (unsigned)WS_KV + (unsigned)((tb + k) * KVCOLS + h * 256 + 128 + c) * 2u; }
    const int vb0 = (int)(uintptr_t)V_lds + v_rd_base(lane);
    int koff[4];
#pragma unroll
    for (int dd = 0; dd < 4; ++dd) koff[dd] = kswz(r32, (dd * 16 + hi * 8) * 2);
    LAS unsigned char* ldsK = (LAS unsigned char*)K_lds + wid * 3072; LAS unsigned char* ldsV = (LAS unsigned char*)V_lds + wid * 2048;
#define DMAK(bo_) do { _Pragma("unroll") for (int j_ = 0; j_ < 3; ++j_) { \
        __builtin_amdgcn_global_load_lds((const unsigned*)(ws + ko[j_]), (LAS unsigned*)(ldsK + (bo_) + j_ * 1024), 16, 0, 0); ko[j_] += ki[j_]; } } while (0)
#define DMAV(bo_) do { _Pragma("unroll") for (int j_ = 0; j_ < 2; ++j_) { \
        __builtin_amdgcn_global_load_lds((const unsigned*)(ws + vo[j_]), (LAS unsigned*)(ldsV + (bo_) + j_ * 1024), 16, 0, 0); vo[j_] += 64u * KVCOLS * 2u; } } while (0)
#define VMW0() asm volatile("s_waitcnt vmcnt(0)" ::: "memory")
    float m_reg = -1e30f, l_reg = 0.f; f32x16 o[4] = {};
    DMAK(0); DMAV(0); DMAK(SHM_K);
    VMW0(); MBAR();
    if (grp == 1) MBAR();
    int kcur = 0, kp2 = 2 * SHM_K;
    int vcur = 0, vnext = SHM_V;
    bf16x8 pa0, pa1, pa2, pa3; f32x16 p0, p1;
#define VALU_HALF(t) do { \
        SBAR(); if ((t) + 2 < NT) DMAK(kp2); if ((t) + 1 < NT) DMAV(vnext); SBAR(); \
        if (64 * (t) + 63 > qlo) { const int dq = qlo + r32 - 4 * hi - 64 * (t); const float NEG = -__builtin_inff(); \
            _Pragma("unroll") for (int r = 0; r < 16; ++r) { const int c = (r & 3) + 8 * (r >> 2); if (dq - c < 0) p0[r] = NEG; if (dq - c - 32 < 0) p1[r] = NEG; } } \
        float pmax = p0[0]; \
        _Pragma("unroll") for (int r = 1; r < 16; ++r) pmax = fmaxf(pmax, p0[r]); \
        _Pragma("unroll") for (int r = 0; r < 16; ++r) pmax = fmaxf(pmax, p1[r]); \
        { auto rr = __builtin_amdgcn_permlane32_swap(__float_as_uint(pmax), __float_as_uint(pmax), false, false); pmax = fmaxf(__uint_as_float(rr[0]), __uint_as_float(rr[1])); } \
          \
        const bool grow_ = __any(pmax > m_reg + 8.0f); \
        const float mn = grow_ ? fmaxf(m_reg, pmax) : m_reg; const float alpha = grow_ ? __builtin_amdgcn_exp2f(m_reg - mn) : 1.0f; m_reg = mn; \
        float ps = 0.f; \
        _Pragma("unroll") for (int r = 0; r < 16; ++r) { p0[r] = __builtin_amdgcn_exp2f(p0[r] - mn); ps += p0[r]; } \
        _Pragma("unroll") for (int r = 0; r < 16; ++r) { p1[r] = __builtin_amdgcn_exp2f(p1[r] - mn); ps += p1[r]; } \
        { auto rr = __builtin_amdgcn_permlane32_swap(__float_as_uint(ps), __float_as_uint(ps), false, false); ps = __uint_as_float(rr[0]) + __uint_as_float(rr[1]); } \
        l_reg = l_reg * alpha + ps; \
        PK4(p0, 0, pa0); PK4(p0, 8, pa1); PK4(p1, 0, pa2); PK4(p1, 8, pa3); \
        if (grow_) { if (hi == 0) al_l[r32] = alpha; asm volatile("s_waitcnt lgkmcnt(0)" ::: "memory"); \
            _Pragma("unroll") for (int d_ = 0; d_ < 4; ++d_) _Pragma("unroll") for (int r = 0; r < 16; ++r) o[d_][r] *= al_l[crow(r, hi)]; } \
        MBAR(); } while (0)
    qkt(p0, p1, K_lds + kcur, koff, qr);
    VMW0(); MBAR();
    for (int t = 0; t + 1 < NT; ++t) {
        VALU_HALF(t);
        kcur = (kcur == 2 * SHM_K) ? 0 : kcur + SHM_K; kp2 = (kp2 == 2 * SHM_K) ? 0 : kp2 + SHM_K;
        pv_tile(o, vb0 + vcur, pa0, pa1, pa2, pa3);
        qkt(p0, p1, K_lds + kcur, koff, qr);
        VMW0(); MBAR();
        vcur = vnext; vnext = (vnext == 2 * SHM_V) ? 0 : vnext + SHM_V;
    }
    VALU_HALF(NT - 1);
    pv_tile(o, vb0 + vcur, pa0, pa1, pa2, pa3);
    MBAR();
    if (grp == 0) MBAR();
#undef VALU_HALF
#undef DMAK
#undef DMAV
#undef VMW0
    { int le = lane; asm volatile("" : "+v"(le)); const int r32e = le & 31, hie = le >> 5;
      if (hie == 0) li_l[r32e] = l_reg; asm volatile("s_waitcnt lgkmcnt(0)" ::: "memory");
#pragma unroll
      for (int r = 0; r < 16; ++r) { const size_t row = tb + qlo + crow(r, hie); const float rl = __builtin_amdgcn_rcpf(li_l[crow(r, hie)]);
#pragma unroll
        for (int d0 = 0; d0 < 4; ++d0) { const int col = h * 128 + d0 * 32 + r32e;
            const float g = bf2f(U[row * UCOLS + 1088 + col]);
            OG[row * DM + col] = f2bf(o[d0][r] * rl * silu_f(g)); } } }
    MBAR();
}
__device__ __forceinline__ void phase(unsigned char* ws, char* lds, int wid) {
    const int G = gridDim.x, bx = blockIdx.x; const int vcu = (G % 8 == 0) ? (bx % 8) * (G / 8) + bx / 8 : bx;
    int grp;
    { unsigned* cnt = (unsigned*)(lds + OFF_WS + 2048);
      const int lane0 = lane_id();
      if (wid == 0 && lane0 < 4) cnt[lane0] = 0u;
      __syncthreads();
      const unsigned simd = (unsigned)__builtin_amdgcn_s_getreg((1 << 11) | (4 << 6) | 4) & 3u;
      unsigned g = 0u; if (lane0 == 0) g = atomicAdd(&cnt[simd], 1u);
      grp = (int)(__builtin_amdgcn_readfirstlane(g) & 1u);
      __syncthreads(); }
    for (int L = vcu; L < 1024; L += G) { const int bh = L >> 5, x = L & 31;
        for (int pass = 0; pass < 2; ++pass) block(bh >> 4, bh & 15, pass ? x : 63 - x, ws, lds, grp, wid);     }
}
}

namespace dil {
__device__ __forceinline__ void wave_item(int w, int gi, const bf16* Gb, const float* gqn, const float* gkn, bf16* OP, float* LSE, char* wlds, int lane) {
    const int r32 = lane & 31, hi = lane >> 5;
    const int sb = w & 511, grp = w >> 9, br = grp % 3, hh = (grp / 3) & 3, b = grp / 12;
    const int dsh = 2 * br, d = 1 << dsh;
    const int nblk = 512 >> dsh, res = sb / nblk, blk = sb % nblk, n0 = blk * 32;
    const size_t tb = (size_t)b * SEQ;
    const int hcol = hh * 1152 + br * 128;
    float* rk_l = (float*)(wlds + 8192); float* al_l = rk_l + 32; float* li_l = al_l + 32;
    const int vb0 = (int)(uintptr_t)wlds + v_rd_base(lane);
    bf16x8 qr[8];
    { const bf16* qp = Gb + (tb + (size_t)(n0 + r32) * d + res) * GCOLS + hcol + hi * 8;
#pragma unroll
      for (int d0 = 0; d0 < 8; ++d0) qr[d0] = *(const bf16x8*)(qp + d0 * 16); }
    const int hg = gi * 4 + hh;
    const float ab = exp2f(-0.5f * (float)(hg + 1)) * (float)d * LOG2E;
    float m_reg = -1e30f, l_reg = 0.f; f32x16 o[4] = {};
    const int jfirst = n0 >= 128 ? 0 : ((128 - n0) >> 5);
    const bf16* kcol = Gb + hcol + 384 + hi * 8; const bf16* vcol = Gb + hcol + 768 + (lane & 15) * 8;
    bf16x8 kf[8]; u32x4 vv[8];
#define DIL_LOAD(j_) do { const int kb_ = n0 - 128 + 32 * (j_); \
        { int nk = kb_ + r32; nk = nk < 0 ? 0 : nk; const bf16* kp = kcol + (tb + (size_t)nk * d + res) * GCOLS; \
          _Pragma("unroll") for (int d0 = 0; d0 < 8; ++d0) kf[d0] = *(const bf16x8*)(kp + d0 * 16); } \
        _Pragma("unroll") for (int i = 0; i < 8; ++i) { int nk = kb_ + (lane >> 4) + 4 * i; nk = nk < 0 ? 0 : nk; \
            vv[i] = *(const u32x4*)(vcol + (tb + (size_t)nk * d + res) * GCOLS); } } while (0)
    DIL_LOAD(jfirst);
    for (int j = jfirst; j < 5; ++j) {
        const int kbase = n0 - 128 + 32 * j;
#pragma unroll
        for (int i = 0; i < 8; ++i) *(u32x4*)(wlds + v_st((lane >> 4) + 4 * i, (lane & 15) * 8)) = vv[i];
        f32x16 p0 = f32x16{};
#pragma unroll
        for (int d0 = 0; d0 < 8; ++d0) p0 = __builtin_amdgcn_mfma_f32_32x32x16_bf16(kf[d0], qr[d0], p0, 0, 0, 0);
        SBAR();
        if (j + 1 < 5) DIL_LOAD(j + 1);
        SBAR();
        asm volatile("s_waitcnt lgkmcnt(0)" ::: "memory");
        const float NEG = -__builtin_inff();
        float pmax = NEG;
#pragma unroll
        for (int r = 0; r < 16; ++r) { const int kc = crow(r, hi); const int nk = kbase + kc; const int rel = n0 + r32 - nk;
            float sv = p0[r] - ab * (float)rel;
            if (rel < 0 || rel > 128 || nk < 0) sv = NEG;
            p0[r] = sv; pmax = fmaxf(pmax, sv); }
        { auto rr = __builtin_amdgcn_permlane32_swap(__float_as_uint(pmax), __float_as_uint(pmax), false, false); pmax = fmaxf(__uint_as_float(rr[0]), __uint_as_float(rr[1])); }
        const float mn = fmaxf(m_reg, pmax); const float alpha = __builtin_amdgcn_exp2f(m_reg - mn); m_reg = mn;
        float ps = 0.f;
#pragma unroll
        for (int r = 0; r < 16; ++r) { p0[r] = __builtin_amdgcn_exp2f(p0[r] - mn); ps += p0[r]; }
        { auto rr = __builtin_amdgcn_permlane32_swap(__float_as_uint(ps), __float_as_uint(ps), false, false); ps = __uint_as_float(rr[0]) + __uint_as_float(rr[1]); }
        l_reg = l_reg * alpha + ps;
        bf16x8 pa0, pa1; PK4(p0, 0, pa0); PK4(p0, 8, pa1);
        if (__any(alpha < 1.f)) { if (hi == 0) al_l[r32] = alpha; asm volatile("s_waitcnt lgkmcnt(0)" ::: "memory");
#pragma unroll
            for (int d_ = 0; d_ < 4; ++d_)
#pragma unroll
                for (int r = 0; r < 16; ++r) o[d_][r] *= al_l[crow(r, hi)]; }
#define PV2(d0) do { s16x4 l0, l1, h0, h1; constexpr int b_ = (d0) * 512; \
        TRRD(l0, b_); TRRD(h0, b_ + 2048); TRRD(l1, b_ + 4096); TRRD(h1, b_ + 6144); \
        asm volatile("s_waitcnt lgkmcnt(0)" ::: "memory"); SBAR(); \
        o[d0] = __builtin_amdgcn_mfma_f32_32x32x16_bf16(pa0, (bf16x8){l0[0], l0[1], l0[2], l0[3], h0[0], h0[1], h0[2], h0[3]}, o[d0], 0, 0, 0);   \
        o[d0] = __builtin_amdgcn_mfma_f32_32x32x16_bf16(pa1, (bf16x8){l1[0], l1[1], l1[2], l1[3], h1[0], h1[1], h1[2], h1[3]}, o[d0], 0, 0, 0); } while (0)
        PV2(0); PV2(1); PV2(2); PV2(3);
#undef PV2
    }
#undef DIL_LOAD
    if (hi == 0) { li_l[r32] = l_reg; LSE[((size_t)br * NTOK + tb + (size_t)(n0 + r32) * d + res) * 4 + hh] = m_reg + __builtin_amdgcn_logf(l_reg); }
    asm volatile("s_waitcnt lgkmcnt(0)" ::: "memory");
    bf16* op = OP + (size_t)br * NTOK * 512;
    float rl[16];
#pragma unroll
    for (int r = 0; r < 16; ++r) rl[r] = __builtin_amdgcn_rcpf(li_l[crow(r, hi)]);
    asm volatile("s_waitcnt lgkmcnt(0)" ::: "memory");
#pragma unroll
    for (int r = 0; r < 16; ++r) { const int qc = crow(r, hi);
#pragma unroll
        for (int d0 = 0; d0 < 4; ++d0) *(unsigned short*)(wlds + qc * 272 + (d0 * 32 + r32) * 2) = f2bf(o[d0][r] * rl[r]); }
    asm volatile("s_waitcnt lgkmcnt(0)" ::: "memory");
#pragma unroll
    for (int i = 0; i < 8; ++i) { const int q = (lane >> 4) + 4 * i; const u32x4 v = *(const u32x4*)(wlds + q * 272 + (lane & 15) * 16);
        const size_t row = tb + (size_t)(n0 + q) * d + res; *(u32x4*)(op + row * 512 + hh * 128 + (lane & 15) * 8) = v; }
    asm volatile("s_waitcnt lgkmcnt(0)" ::: "memory");
}
}

__global__ void __launch_bounds__(512, 2) yoco_fwd(Args args) {
    extern __shared__ __attribute__((aligned(16))) unsigned char lds[];
    cg::grid_group grid = cg::this_grid();
    const int wave = __builtin_amdgcn_readfirstlane((int)threadIdx.x >> 6);
#define lane lane_id()
    const int G = gridDim.x; const int gw = blockIdx.x * 8 + wave, ngw = G * 8;
    unsigned char* ws = args.ws;
    const int lo = args.ph_lo, hi = args.ph_hi;
#define IN(k) (lo <= (k) && (k) < hi)
#define SEAM(k) do { if ((k) + 1 < hi) grid.sync(); } while (0)
    if (IN(0)) {
      for (int rep = 0; rep < (DUP == 100 ? 2 : 1); ++rep) {
        LAS float* scr = (LAS float*)((LAS unsigned char*)lds + wave * 16384);
        int base = 0;
#define TR_MAT(Wp, Kc, Nc, Gp, Tp, Mp) do { const int ni = ((Kc) / 64) * ((Nc) / 32); int first = (gw - base) % ngw; if (first < 0) first += ngw; \
            for (int it = first; it < ni; it += ngw) transpose_item((Wp), (Kc), (Nc), (Gp), (Tp), (Mp), scr, it, lane); base += ni; } while (0)
        TR_MAT(args.in[2], 2048, 3136, args.in[1], (bf16*)(ws + WS_WAIN), 0);
        TR_MAT(args.in[4], 512, 3072, args.in[3], (bf16*)(ws + WS_WQUP), 0);
        TR_MAT(args.in[6], 512, 4096, args.in[5], (bf16*)(ws + WS_WKVUP), 0);
        TR_MAT(args.in[9], 2048, 2048, (const float*)nullptr, (bf16*)(ws + WS_WAO), 0);
        TR_MAT(args.in[11], 2048, 12288, args.in[10], (bf16*)(ws + WS_WBALL), 1);
        TR_MAT(args.in[14], 2048, 8192, args.in[13], (bf16*)(ws + WS_WBALL), 2);
        TR_MAT(args.in[16], 2048, 2048, (const float*)nullptr, (bf16*)(ws + WS_WBO), 0);
#undef TR_MAT
        if (NTOK % (4 * ngw) == 0) { for (int m = gw; m < NTOK; m += 4 * ngw) norm_row4_nt(args.in[0] + (size_t)m * DM, (bf16*)(ws + WS_XN) + (size_t)m * DM, (size_t)ngw * DM, lane); }
        else { for (int m = gw; m < NTOK; m += ngw) norm_row(args.in[0] + (size_t)m * DM, (bf16*)(ws + WS_XN) + (size_t)m * DM, lane); }
        { float* COS = (float*)(ws + WS_ROPE); float* SIN = COS + SEQ * 32;
          for (int idx = gw * 64 + lane; idx < SEQ * 32; idx += ngw * 64) { float c, sn; sincos_pos(idx >> 5, idx & 31, c, sn); COS[idx] = c; SIN[idx] = sn; } }
      }
        SEAM(0);
    }
    if (IN(1)) {
        const pg8::Gemm g{(bf16*)(ws + WS_XN), (bf16*)(ws + WS_WAIN), NTOK, UCOLS, 2048, 2048};
        const pg8::EpiSt E{(bf16*)(ws + WS_U), UCOLS, 1 << 30, nullptr, 0, 0};
        pg8::StaticOrder S; S.init(g.M, g.N, G, (int)blockIdx.x);
#ifndef SK_G1
        for (int rep = 0; rep < (DUP == 1 ? 2 : 1); ++rep)
        pg8::gemm_phase<pg8::EpiSt, pg8::StaticOrder, true, true, 2048, 2048>((LAS unsigned char*)lds, g, S, E, wave);
#endif
        SEAM(1);
    }
    if (IN(2)) {
        for (int cj = 0; cj < (DUP == 2 ? 4 : 2); ++cj) { const int ci = cj & 1;
            const pg8::Gemm g{(bf16*)(ws + WS_U) + (ci ? 512 : 0), (bf16*)(ws + (ci ? WS_WKVUP : WS_WQUP)), NTOK, ci ? KVCOLS : QCOLS, 512, UCOLS};
            const pg8::EpiSt E{(bf16*)(ws + (ci ? WS_KV : WS_Q)), ci ? KVCOLS : QCOLS, 1 << 30, nullptr, 0, 0};
            pg8::StaticOrder S; S.init(g.M, g.N, G, (int)blockIdx.x);
#ifndef SK_G1
            pg8::gemm_phase<pg8::EpiSt, pg8::StaticOrder, true, true, 512, UCOLS>((LAS unsigned char*)lds, g, S, E, wave);
#endif
        }
        SEAM(2);
    }
    if (IN(3)) {
#ifndef SK_QKN
        { int l3 = lane; asm volatile("" : "+v"(l3)); qknorm_phase(ws, args.in[7], args.in[8], gw, ngw, l3); }
#endif
        SEAM(3);
    }
    if (IN(4)) {
#ifndef SK_MLA
        for (int rep = 0; rep < (DUP == 4 ? 2 : 1); ++rep) mla::phase(ws, (char*)lds, wave);
#endif
        SEAM(4);
    }
    if (IN(5)) {
        const pg8::Gemm g{(bf16*)(ws + WS_XN), (bf16*)(ws + WS_WAO), NTOK, DM, 2048, 2048};
        const pg8::EpiRes E{args.in[0], args.out, DM, true, false};
        pg8::StaticOrder S; S.init(g.M, g.N, G, (int)blockIdx.x);
#ifndef SK_G2
        for (int rep = 0; rep < (DUP == 5 ? 2 : 1); ++rep)
        pg8::gemm_phase<pg8::EpiRes, pg8::StaticOrder, true, true, 2048, 2048>((LAS unsigned char*)lds, g, S, E, wave);
#endif
        SEAM(5);
    }
    if (IN(6)) {
        if (DUP == 66) { for (int rep = 0; rep < 20; ++rep) grid.sync(); }
        for (int rep = 0; rep < (DUP == 6 ? 2 : 1); ++rep)
        for (int m = gw; m < NTOK; m += 2 * ngw) { if (m + ngw < NTOK) norm_row2<false>(args.out + (size_t)m * DM, (bf16*)(ws + WS_XN) + (size_t)m * DM, args.out + (size_t)(m + ngw) * DM, (bf16*)(ws + WS_XN) + (size_t)(m + ngw) * DM, lane);
            else norm_row(args.out + (size_t)m * DM, (bf16*)(ws + WS_XN) + (size_t)m * DM, lane); }
        SEAM(6);
    }
    for (int it = 0; it < (DUP == 7 ? 8 : 4); ++it) { const int gi = it & 3;
        if (IN(7 + 3 * gi)) {
            const pg8::Gemm g{(bf16*)(ws + WS_XN), (bf16*)(ws + WS_WBALL) + (size_t)gi * GN * 2048, NTOK, GN, 2048, 2048};
            const pg8::EpiStNorm E{(bf16*)(ws + WS_G), GCOLS, 18, (bf16*)(ws + WS_GATE), DM, gi * 512, args.in[15], args.in[12], (LAS float*)((LAS unsigned char*)lds + 131072), QSCALE_B, EPSN};
            pg8::StaticOrder S; S.init(g.M, g.N, G, (int)blockIdx.x);
#ifndef SK_G1
            pg8::gemm_phase<pg8::EpiStNorm, pg8::StaticOrder, true, true, 2048, 2048>((LAS unsigned char*)lds, g, S, E, wave);
#endif
            SEAM(7 + 3 * gi);
        }
        if (IN(8 + 3 * gi)) {
#ifndef SK_DIL
            int lane2 = lane; asm volatile("" : "+v"(lane2));
            char* wlds = (char*)lds + wave * 16384;
            const int gwx = (G % 8 == 0) ? ((int)(blockIdx.x & 7) * (G / 8) + (int)(blockIdx.x >> 3)) * 8 + wave : gw;
            for (int rep = 0; rep < (DUP == 8 ? 2 : 1); ++rep)
            for (int w = gwx; w < 12288; w += ngw)
                dil::wave_item(w, gi, (const bf16*)(ws + WS_G), args.in[15], args.in[12], (bf16*)(ws + WS_OP), (float*)(ws + WS_LSE), wlds, lane2);
#endif
            SEAM(8 + 3 * gi);
        }
        if (IN(9 + 3 * gi)) {
            int lane2 = lane; asm volatile("" : "+v"(lane2));
            const int hh = lane2 >> 4, e0 = 8 * (lane2 & 15);
            const bf16* OP = (const bf16*)(ws + WS_OP); const float* LSE = (const float*)(ws + WS_LSE);
            const bf16* GATE = (const bf16*)(ws + WS_GATE); bf16* OG = (bf16*)(ws + WS_OG);
            for (int t0 = gw; t0 < NTOK; t0 += 2 * ngw) {
                float ls[2][3]; u32x4 ov[2][3], gv[2]; size_t oc[2]; bool ok[2];
#pragma unroll
                for (int k = 0; k < 2; ++k) { const int t = t0 + k * ngw; ok[k] = t < NTOK; const int tc = ok[k] ? t : t0;
                    oc[k] = (size_t)tc * DM + (gi * 4 + hh) * 128 + e0;
#pragma unroll
                    for (int br = 0; br < 3; ++br) { ls[k][br] = __builtin_nontemporal_load(LSE + ((size_t)br * NTOK + tc) * 4 + hh); ov[k][br] = __builtin_nontemporal_load((const u32x4*)(OP + ((size_t)br * NTOK + tc) * 512 + hh * 128 + e0)); }
                    gv[k] = __builtin_nontemporal_load((const u32x4*)(GATE + oc[k])); }
#pragma unroll
                for (int k = 0; k < 2; ++k) {
                    const float mx = fmaxf(ls[k][0], fmaxf(ls[k][1], ls[k][2]));
                    float w0 = __builtin_amdgcn_exp2f(ls[k][0] - mx), w1 = __builtin_amdgcn_exp2f(ls[k][1] - mx), w2 = __builtin_amdgcn_exp2f(ls[k][2] - mx);
                    const float inv = __builtin_amdgcn_rcpf(w0 + w1 + w2); w0 *= inv; w1 *= inv; w2 *= inv;
                    u32x4 res;
#pragma unroll
                    for (int j = 0; j < 4; ++j) {
                        const float a = w0 * bflo(ov[k][0][j]) + w1 * bflo(ov[k][1][j]) + w2 * bflo(ov[k][2][j]);
                        const float c = w0 * bfhi(ov[k][0][j]) + w1 * bfhi(ov[k][1][j]) + w2 * bfhi(ov[k][2][j]);
                        res[j] = cvtpk(a * silu_f(bflo(gv[k][j])), c * silu_f(bfhi(gv[k][j]))); }
                    if (ok[k]) *(u32x4*)(OG + oc[k]) = res; }
            }
            if (gi == 3) SEAM(9 + 3 * gi);
        }
    }
    if (IN(19)) {
        const pg8::Gemm g{(bf16*)(ws + WS_OG), (bf16*)(ws + WS_WBO), NTOK, DM, 2048, 2048};
        const pg8::EpiRes E{args.out, args.out, DM, true, true};
        pg8::StaticOrder S; S.init(g.M, g.N, G, (int)blockIdx.x);
#ifndef SK_G2
        pg8::gemm_phase<pg8::EpiRes, pg8::StaticOrder, true, true, 2048, 2048>((LAS unsigned char*)lds, g, S, E, wave);
#endif
    }
#undef IN
#undef SEAM
#undef lane
}

#ifndef ONE_LAUNCH
#define ONE_LAUNCH 1
#endif
extern "C" void kernel_launch(void* const* d_in, const int* in_sizes, int n_in, void* d_out, int out_size, void* d_ws, size_t ws_size, hipStream_t stream) {
    static int grid = 0;
    if (grid == 0) {
        if (n_in != 17 || in_sizes[0] != NTOK * DM || out_size != NTOK * DM || ws_size < WS_END) {
            fprintf(stderr, "kernel_launch: unexpected shapes (n_in %d, in0 %d, out %d, ws %zu < %zu)\n", n_in, n_in > 0 ? in_sizes[0] : -1, out_size, ws_size, (size_t)WS_END); grid = -1; return; }
        int dev = 0, cus = 0, per_cu = 0;
        (void)hipGetDevice(&dev); (void)hipDeviceGetAttribute(&cus, hipDeviceAttributeMultiprocessorCount, dev);
        if (hipFuncSetAttribute((const void*)yoco_fwd, hipFuncAttributeMaxDynamicSharedMemorySize, LDS_BYTES) != hipSuccess) { fprintf(stderr, "kernel_launch: hipFuncSetAttribute failed\n"); grid = -1; return; }
        (void)hipOccupancyMaxActiveBlocksPerMultiprocessor(&per_cu, (const void*)yoco_fwd, 512, LDS_BYTES);
        (void)hipGetLastError();
        if (per_cu < 1) per_cu = 1;
        grid = cus > 0 ? cus : 256;
    }
    if (grid < 0) return;
    Args a{};
    for (int i = 0; i < 17; ++i) a.in[i] = (const float*)d_in[i];
    a.out = (float*)d_out; a.ws = (unsigned char*)d_ws;
#if ONE_LAUNCH
    a.ph_lo = 0; a.ph_hi = NPHASE;
    void* kargs[] = {&a};
    hipError_t e = hipLaunchCooperativeKernel((const void*)yoco_fwd, dim3(grid), dim3(512), kargs, LDS_BYTES, stream);
    if (e != hipSuccess) fprintf(stderr, "cooperative launch failed: %s (grid %d)\n", hipGetErrorString(e), grid);
#else
    for (int ph = 0; ph < NPHASE; ++ph) { a.ph_lo = ph; a.ph_hi = ph + 1;
        hipLaunchKernelGGL(yoco_fwd, dim3(grid), dim3(512), LDS_BYTES, stream, a); }
#endif
}
```

```cpp
#include <hip/hip_runtime.h>
#include <hip/hip_cooperative_groups.h>
#include <cstdio>
#include <cstdint>
namespace cg = cooperative_groups;
__device__ __forceinline__ int lane_id() { return (int)__builtin_amdgcn_mbcnt_hi(~0u, __builtin_amdgcn_mbcnt_lo(~0u, 0u)); }
namespace pg8 {
#define PG8_LAS __attribute__((address_space(3)))
typedef unsigned short bf16_t;
typedef short bf16x8 __attribute__((ext_vector_type(8)));
typedef float f32x4 __attribute__((ext_vector_type(4)));
typedef unsigned u32x4 __attribute__((ext_vector_type(4)));
constexpr int BM = 256, BK = 64, HALF = 128, HTB = HALF * BK * 2  , STAGE_BYTES = 8 * HTB, NXCD = 8, WGM = 4;

__host__ __device__ __forceinline__ int lds_byte(int r, int c) { const int st = (r >> 4) * 2 + (c >> 5), rr = r & 15, cc = c & 31, ob = rr * 64 + cc * 2; return st * 1024 + (ob ^ (((ob >> 9) & 1) << 5)); }
__host__ __device__ __forceinline__ void stage_rc(int b, int& R, int& C) { const int st = b / 1024, sb = b % 1024, swz = sb ^ (((sb >> 9) & 1) << 5); R = (st >> 1) * 16 + swz / 64; C = (st & 1) * 32 + (swz % 64) / 2; }
__host__ __device__ __forceinline__ int perm32(int rho) { const int n = rho >> 4, i = rho & 15; return 8 * (i >> 2) + 4 * n + (i & 3); }

struct Unit { int pm, pn; };
struct Gemm { const bf16_t* A; const bf16_t* Bt; int M, N, K, lda; };

struct StaticOrder {
    int nM, nN, nwg, G, c;
    __host__ __device__ void init(int M, int N, int G_, int c_) { nM = M / BM; nN = N / BM; nwg = nM * nN; G = G_; c = c_; }
    __host__ __device__ bool next(int i, Unit& u) const {
        const long L = (long)i * G + c; if (L >= nwg) return false;
        int wgid = (int)L; { const int q = nwg / NXCD, r = nwg % NXCD, xcd = wgid % NXCD, off = wgid / NXCD; wgid = (xcd < r ? xcd * (q + 1) : r * (q + 1) + (xcd - r) * q) + off; }
        const int nig = WGM * nN, gid = wgid / nig, fm = gid * WGM, gsz = (nM - fm) < WGM ? (nM - fm) : WGM;
        u.pm = fm + ((wgid % nig) % gsz); u.pn = (wgid % nig) / gsz; return true;
    }
    __device__ __forceinline__ void a_ready(const Unit&) const {}
    __device__ __forceinline__ void done(const Unit&) const {}
};

__device__ __forceinline__ unsigned cvt_pk_bf16(float lo, float hi) { unsigned r; asm volatile("v_cvt_pk_bf16_f32 %0, %1, %2" : "=v"(r) : "v"(lo), "v"(hi)); return r; }
template <class Epi, class Sched, bool ALIGN_EPI, bool SP2, int KC, int LDAC>
__device__ __forceinline__ void gemm_phase(PG8_LAS unsigned char* lds, const Gemm g, const Sched& S, const Epi& E, int wid_in) {
    const int wid = __builtin_amdgcn_readfirstlane(wid_in), lane = lane_id(), tid = wid * 64 + lane, wr = wid >> 2, wc = wid & 3, fr = lane & 15, fq = lane >> 4;
    constexpr int K = KC, nt = K / BK, lda = LDAC;
    unsigned voffA[2], voffB[2];
#pragma unroll
    for (int i = 0; i < 2; ++i) { int R, C; stage_rc(tid * 16 + i * 8192, R, C); const int Rb = Epi::PERM ? ((R & ~31) + perm32(R & 31)) : R;
        voffA[i] = (unsigned)(R * lda + C) * 2u; voffB[i] = (unsigned)(Rb * K + C) * 2u; }
    const size_t kstep = (size_t)(BK * 2);
    const size_t hstep = (size_t)HALF * K * 2;
    const size_t tstep = 2 * hstep; const size_t hstepA = (size_t)HALF * lda * 2, tstepA = 2 * hstepA;
    const unsigned ldsw = (unsigned)wid * 1024u;
    const int aoff = lds_byte(wr * 64 + fr, fq * 8), boff = lds_byte(wc * 32 + fr, fq * 8);
#define PG8_SA(b, h) (((b) * 2 + (h)) * HTB)
#define PG8_SB(b, h) ((4 + (b) * 2 + (h)) * HTB)
#define PG8_STAGE(bufoff, gbase, voff) do { _Pragma("unroll") for (int _i = 0; _i < 2; ++_i) \
        __builtin_amdgcn_global_load_lds((const unsigned*)((const char*)(gbase) + (voff)[_i]), (PG8_LAS unsigned*)(lds + (bufoff) + ldsw + _i * 8192), 16, 0, 0); } while (0)
#define PG8_LDA(dst, b, h) do { _Pragma("unroll") for (int m = 0; m < 4; ++m) _Pragma("unroll") for (int k = 0; k < 2; ++k) dst[m][k] = *(const PG8_LAS bf16x8*)(lds + PG8_SA(b, h) + aoff + m * 2048 + k * 1024); } while (0)
#define PG8_LDB(dst, b, h) do { _Pragma("unroll") for (int n = 0; n < 2; ++n) _Pragma("unroll") for (int k = 0; k < 2; ++k) dst[n][k] = *(const PG8_LAS bf16x8*)(lds + PG8_SB(b, h) + boff + n * 2048 + k * 1024); } while (0)
#define PG8_MMA(ai, bj, At, Bt) do { __builtin_amdgcn_s_setprio(1); _Pragma("unroll") for (int m = 0; m < 4; ++m) _Pragma("unroll") for (int n = 0; n < 2; ++n) _Pragma("unroll") for (int k = 0; k < 2; ++k) \
        acc[ai][bj][m][n] = __builtin_amdgcn_mfma_f32_16x16x32_bf16(Bt[n][k], At[m][k], acc[ai][bj][m][n], 0, 0, 0); __builtin_amdgcn_s_setprio(0); } while (0)
#define PG8_WAIT_V(n) asm volatile("s_waitcnt vmcnt(" #n ")" ::: "memory")
#define PG8_WAIT_L(n) asm volatile("s_waitcnt lgkmcnt(" #n ")" ::: "memory")
#define PG8_BAR __builtin_amdgcn_s_barrier()
#define PG8_SCHED __builtin_amdgcn_sched_barrier(0)
    Unit cur, nxt; int ui = 0;
    if (!S.next(0, cur)) return;
    f32x4 acc[2][2][4][2];
#pragma unroll
    for (int a = 0; a < 2; ++a)
#pragma unroll
        for (int b = 0; b < 2; ++b)
#pragma unroll
            for (int m = 0; m < 4; ++m)
#pragma unroll
                for (int n = 0; n < 2; ++n) acc[a][b][m][n] = (f32x4){0.f, 0.f, 0.f, 0.f};
    bf16x8 At[4][2], B0[2][2], B1[2][2];
    const char* cA = (const char*)g.A + (size_t)cur.pm * tstepA; const char* cB = (const char*)g.Bt + (size_t)cur.pn * tstep;
    S.a_ready(cur);
    if constexpr (SP2) {
        PG8_STAGE(PG8_SB(0, 0), cB, voffB); PG8_STAGE(PG8_SB(0, 1), cB + hstep, voffB); PG8_STAGE(PG8_SA(0, 0), cA, voffA); PG8_STAGE(PG8_SA(0, 1), cA + hstepA, voffA);
        if (wr == 1) PG8_BAR;
        PG8_WAIT_V(2); PG8_BAR;
        PG8_STAGE(PG8_SB(1, 0), cB + kstep, voffB); PG8_STAGE(PG8_SA(1, 0), cA + kstep, voffA); PG8_STAGE(PG8_SB(1, 1), cB + hstep + kstep, voffB);
        PG8_WAIT_V(6); PG8_BAR;
    } else {
        PG8_STAGE(PG8_SB(0, 0), cB, voffB); PG8_STAGE(PG8_SA(0, 0), cA, voffA); PG8_STAGE(PG8_SB(0, 1), cB + hstep, voffB); PG8_STAGE(PG8_SA(0, 1), cA + hstepA, voffA);
        if (wr == 1) PG8_BAR;
        PG8_WAIT_V(4); PG8_BAR;
        PG8_STAGE(PG8_SB(1, 0), cB + kstep, voffB); PG8_STAGE(PG8_SA(1, 0), cA + kstep, voffA); PG8_STAGE(PG8_SB(1, 1), cB + hstep + kstep, voffB);
        PG8_WAIT_V(6); PG8_BAR;
    }
    for (;;) {
        const bool has_next = S.next(ui + 1, nxt);
        const char* nA = has_next ? (const char*)g.A + (size_t)nxt.pm * tstepA : cA; const char* nB = has_next ? (const char*)g.Bt + (size_t)nxt.pn * tstep : cB;
        for (int t = 0; t < nt; t += 2) {
            const bool last = (t == nt - 2);
            const char* a1 = cA + (size_t)(t + 1) * kstep;
            const char* a2 = last ? nA : cA + (size_t)(t + 2) * kstep; const char* b2 = last ? nB : cB + (size_t)(t + 2) * kstep;
            const char* a3 = a2 + kstep; const char* b3 = b2 + kstep;
            if (last && has_next) S.a_ready(nxt);
            if constexpr (SP2) {
            PG8_LDB(B0, 0, 0); PG8_LDB(B1, 0, 1); PG8_SCHED; PG8_LDA(At, 0, 0); PG8_STAGE(PG8_SA(1, 1), a1 + hstepA, voffA);
            PG8_WAIT_V(8); PG8_WAIT_L(0); PG8_BAR; PG8_MMA(0, 0, At, B0); PG8_MMA(0, 1, At, B1); PG8_BAR; PG8_SCHED;
            PG8_LDA(At, 0, 1); PG8_STAGE(PG8_SB(0, 0), b2, voffB); PG8_STAGE(PG8_SB(0, 1), b2 + hstep, voffB); PG8_STAGE(PG8_SA(0, 0), a2, voffA);
            PG8_WAIT_V(8); PG8_WAIT_L(0); PG8_BAR; PG8_MMA(1, 0, At, B0); PG8_MMA(1, 1, At, B1); PG8_BAR; PG8_SCHED;
            PG8_LDB(B0, 1, 0); PG8_LDB(B1, 1, 1); PG8_SCHED; PG8_LDA(At, 1, 0); PG8_STAGE(PG8_SA(0, 1), a2 + hstepA, voffA);
            PG8_WAIT_V(8); PG8_WAIT_L(0); PG8_BAR; PG8_MMA(0, 0, At, B0); PG8_MMA(0, 1, At, B1); PG8_BAR; PG8_SCHED;
            PG8_LDA(At, 1, 1); PG8_STAGE(PG8_SB(1, 0), b3, voffB); PG8_STAGE(PG8_SB(1, 1), b3 + hstep, voffB); PG8_STAGE(PG8_SA(1, 0), a3, voffA);
            PG8_WAIT_V(8); PG8_WAIT_L(0); PG8_BAR; PG8_MMA(1, 0, At, B0); PG8_MMA(1, 1, At, B1); PG8_BAR; PG8_SCHED;
            } else {
            PG8_LDB(B0, 0, 0); PG8_SCHED; PG8_LDA(At, 0, 0); PG8_STAGE(PG8_SA(1, 1), a1 + hstepA, voffA);
            PG8_WAIT_L(8); PG8_BAR; PG8_WAIT_L(0); PG8_MMA(0, 0, At, B0); PG8_BAR; PG8_SCHED;
            PG8_LDB(B1, 0, 1); PG8_STAGE(PG8_SB(0, 0), b2, voffB);
            PG8_BAR; PG8_WAIT_L(0); PG8_MMA(0, 1, At, B1); PG8_BAR;
            PG8_LDA(At, 0, 1); PG8_STAGE(PG8_SA(0, 0), a2, voffA);
            PG8_BAR; PG8_WAIT_L(0); PG8_MMA(1, 0, At, B0); PG8_BAR; PG8_SCHED;
            PG8_STAGE(PG8_SB(0, 1), b2 + hstep, voffB);
            PG8_WAIT_V(6); PG8_BAR; PG8_MMA(1, 1, At, B1); PG8_BAR;
            PG8_LDB(B0, 1, 0); PG8_SCHED; PG8_LDA(At, 1, 0); PG8_STAGE(PG8_SA(0, 1), a2 + hstepA, voffA);
            PG8_WAIT_L(8); PG8_BAR; PG8_WAIT_L(0); PG8_MMA(0, 0, At, B0); PG8_BAR; PG8_SCHED;
            PG8_LDB(B1, 1, 1); PG8_STAGE(PG8_SB(1, 0), b3, voffB);
            PG8_BAR; PG8_WAIT_L(0); PG8_MMA(0, 1, At, B1); PG8_BAR;
            PG8_LDA(At, 1, 1); PG8_STAGE(PG8_SA(1, 0), a3, voffA);
            PG8_BAR; PG8_WAIT_L(0); PG8_MMA(1, 0, At, B0); PG8_BAR; PG8_SCHED;
            PG8_STAGE(PG8_SB(1, 1), b3 + hstep, voffB);
            PG8_WAIT_V(6); PG8_BAR; PG8_MMA(1, 1, At, B1); PG8_BAR;
            }
        }
        if constexpr (ALIGN_EPI) { if (wr == 0) PG8_BAR; }
        if constexpr (!Epi::AFTER_DRAIN) { E(acc, cur, wr, wc, fr, fq); S.done(cur); }
        if (!has_next) break;
#pragma unroll
        for (int a = 0; a < 2; ++a)
#pragma unroll
            for (int b = 0; b < 2; ++b)
#pragma unroll
                for (int m = 0; m < 4; ++m)
#pragma unroll
                    for (int n = 0; n < 2; ++n) acc[a][b][m][n] = (f32x4){0.f, 0.f, 0.f, 0.f};
        cur = nxt; cA = nA; cB = nB; ++ui;
        if constexpr (ALIGN_EPI) { if (wr == 1) PG8_BAR; }
    }
    PG8_WAIT_V(0);
    if constexpr (!ALIGN_EPI) { if (wr == 0) PG8_BAR; }
    PG8_BAR;
    if constexpr (Epi::AFTER_DRAIN) { E.fused(acc, cur, wr, wc, fr, fq, lds, wid, lane); S.done(cur); }
#undef PG8_SA
#undef PG8_SB
#undef PG8_STAGE
#undef PG8_LDA
#undef PG8_LDB
#undef PG8_MMA
#undef PG8_WAIT_V
#undef PG8_WAIT_L
#undef PG8_BAR
#undef PG8_SCHED
}
}

namespace pg8 {
struct EpiSt {
    static constexpr bool PERM = true, AFTER_DRAIN = false;
    bf16_t* O; int ldc; int ncut; bf16_t* O2; int ldc2; int col2;
    __device__ __forceinline__ void operator()(const f32x4 (&acc)[2][2][4][2], const Unit& u, int wr, int wc, int fr, int fq) const {
        const int row0 = u.pm * BM + wr * 64 + fr;
        bf16_t* base = O; int ld = ldc; int colt = u.pn * BM;
        if (u.pn >= ncut) { base = O2; ld = ldc2; colt = col2 + (u.pn - ncut) * BM; }
        const int col0 = colt + wc * 32 + 8 * fq;
#pragma unroll
        for (int ai = 0; ai < 2; ++ai)
#pragma unroll
            for (int m = 0; m < 4; ++m) { bf16_t* rowp = base + (size_t)(row0 + ai * HALF + m * 16) * ld + col0;
#pragma unroll
                for (int bj = 0; bj < 2; ++bj) { const f32x4 v0 = acc[ai][bj][m][0], v1 = acc[ai][bj][m][1];
                    u32x4 w; w.x = cvt_pk_bf16(v0[0], v0[1]); w.y = cvt_pk_bf16(v0[2], v0[3]); w.z = cvt_pk_bf16(v1[0], v1[1]); w.w = cvt_pk_bf16(v1[2], v1[3]);
                    *(u32x4*)(rowp + bj * HALF) = w; } }
    }
};
struct EpiStNorm {
    static constexpr bool PERM = true, AFTER_DRAIN = false;
    bf16_t* O; int ldc; int ncut; bf16_t* O2; int ldc2; int col2; const float* gq; const float* gk; PG8_LAS float* P; float qscale, eps;
    __device__ __forceinline__ void operator()(const f32x4 (&acc)[2][2][4][2], const Unit& u, int wr, int wc, int fr, int fq) const {
        const int row0 = u.pm * BM + wr * 64 + fr;
        const bool gate = u.pn >= ncut;
        bf16_t* base = O; int ld = ldc; int colt = u.pn * BM;
        if (gate) { base = O2; ld = ldc2; colt = col2 + (u.pn - ncut) * BM; }
        const int col0 = colt + wc * 32 + 8 * fq;
        int part[2], br[2];
#pragma unroll
        for (int bj = 0; bj < 2; ++bj) { const int rem = (u.pn * 2 + bj) % 9; part[bj] = gate ? 2 : rem / 3; br[bj] = rem % 3; }
        f32x4 cg[2][2];
#pragma unroll
        for (int bj = 0; bj < 2; ++bj) {
            cg[bj][0] = (f32x4){1.f, 1.f, 1.f, 1.f}; cg[bj][1] = cg[bj][0];
            if (part[bj] == 0) { const int e = br[bj] * 128 + wc * 32 + 8 * fq;
                cg[bj][0] = *(const f32x4*)(gq + e) * *(const f32x4*)(gk + e) * qscale; cg[bj][1] = *(const f32x4*)(gq + e + 4) * *(const f32x4*)(gk + e + 4) * qscale; } }
        float sc[2][2][4];
#pragma unroll
        for (int ai = 0; ai < 2; ++ai)
#pragma unroll
            for (int bj = 0; bj < 2; ++bj)
#pragma unroll
                for (int m = 0; m < 4; ++m) sc[ai][bj][m] = 1.f;
        if (part[0] < 2 || part[1] < 2) {
#pragma unroll
            for (int ai = 0; ai < 2; ++ai)
#pragma unroll
                for (int bj = 0; bj < 2; ++bj)
#pragma unroll
                    for (int m = 0; m < 4; ++m) if (part[bj] < 2) { const f32x4 a = acc[ai][bj][m][0], b = acc[ai][bj][m][1];
                        float q = (a[0] * a[0] + a[1] * a[1]) + (a[2] * a[2] + a[3] * a[3]) + (b[0] * b[0] + b[1] * b[1]) + (b[2] * b[2] + b[3] * b[3]);
                        { auto rr = __builtin_amdgcn_permlane16_swap(__float_as_uint(q), __float_as_uint(q), false, false); q = __uint_as_float(rr[0]) + __uint_as_float(rr[1]); }
                        { auto rr = __builtin_amdgcn_permlane32_swap(__float_as_uint(q), __float_as_uint(q), false, false); q = __uint_as_float(rr[0]) + __uint_as_float(rr[1]); }
                        if (fq == 0) P[(bj * 256 + ai * HALF + wr * 64 + m * 16 + fr) * 4 + wc] = q; }
            asm volatile("s_waitcnt lgkmcnt(0)\n\ts_barrier" ::: "memory");
#pragma unroll
            for (int ai = 0; ai < 2; ++ai)
#pragma unroll
                for (int bj = 0; bj < 2; ++bj)
#pragma unroll
                    for (int m = 0; m < 4; ++m) if (part[bj] < 2) { const f32x4 t = *(const PG8_LAS f32x4*)(P + (bj * 256 + ai * HALF + wr * 64 + m * 16 + fr) * 4);
                        sc[ai][bj][m] = __builtin_amdgcn_rsqf(((t[0] + t[1]) + (t[2] + t[3])) * (1.0f / 128.0f) + eps); }
        }
#pragma unroll
        for (int ai = 0; ai < 2; ++ai)
#pragma unroll
            for (int m = 0; m < 4; ++m) { bf16_t* rowp = base + (size_t)(row0 + ai * HALF + m * 16) * ld + col0;
#pragma unroll
                for (int bj = 0; bj < 2; ++bj) { const f32x4 v0 = acc[ai][bj][m][0] * cg[bj][0] * sc[ai][bj][m], v1 = acc[ai][bj][m][1] * cg[bj][1] * sc[ai][bj][m];
                    u32x4 w; w.x = cvt_pk_bf16(v0[0], v0[1]); w.y = cvt_pk_bf16(v0[2], v0[3]); w.z = cvt_pk_bf16(v1[0], v1[1]); w.w = cvt_pk_bf16(v1[2], v1[3]);
                    *(u32x4*)(rowp + bj * HALF) = w; } }
    }
};
struct EpiRes {
    static constexpr bool PERM = false, AFTER_DRAIN = false;
    const float* base; float* out; int ldc; bool nt_ld, nt_st;
    __device__ __forceinline__ void operator()(const f32x4 (&acc)[2][2][4][2], const Unit& u, int wr, int wc, int fr, int fq) const {
        const int col0 = u.pn * BM + wc * 32 + 4 * fq;
#pragma unroll
        for (int ai = 0; ai < 2; ++ai) {
            const size_t off0 = (size_t)(u.pm * BM + ai * HALF + wr * 64 + fr) * ldc + col0;
            f32x4 bs[4][2][2];
#pragma unroll
            for (int m = 0; m < 4; ++m)
#pragma unroll
                for (int bj = 0; bj < 2; ++bj)
#pragma unroll
                    for (int n = 0; n < 2; ++n) { const f32x4* p_ = (const f32x4*)(base + off0 + (size_t)m * 16 * ldc + bj * HALF + n * 16); bs[m][bj][n] = nt_ld ? __builtin_nontemporal_load(p_) : *p_; }
            asm volatile("" ::: "memory");
#pragma unroll
            for (int m = 0; m < 4; ++m)
#pragma unroll
                for (int bj = 0; bj < 2; ++bj)
#pragma unroll
                    for (int n = 0; n < 2; ++n) { f32x4* q_ = (f32x4*)(out + off0 + (size_t)m * 16 * ldc + bj * HALF + n * 16); const f32x4 r_ = bs[m][bj][n] + acc[ai][bj][m][n]; if (nt_st) __builtin_nontemporal_store(r_, q_); else *q_ = r_; }
            asm volatile("" ::: "memory");
        }
    }
};
}

constexpr int SEQ = 16384, NTOK = 32768, DM = 2048;
constexpr int UCOLS = 3328;
constexpr int QCOLS = 3072, KVCOLS = 4096, KRCOLS = 1024;
constexpr int GCOLS = 4608, GN = 5120;
constexpr float EPSN = 1e-6f;
constexpr float LOG2E = 1.4426950408889634f;
constexpr float QSCALE_A = 0.10411754627697264f;
constexpr float QSCALE_B = 0.12751743082459868f;
constexpr size_t MiB = 1u << 20;
constexpr size_t WS_WAIN = 0, WS_WQUP = 14 * MiB, WS_WKVUP = 17 * MiB, WS_WAO = 21 * MiB, WS_WBALL = 29 * MiB, WS_WBO = 109 * MiB;
constexpr size_t WS_LSE = 120 * MiB, WS_ROPE = 122 * MiB;
constexpr size_t WS_XN = 144 * MiB;
constexpr size_t WS_U = 272 * MiB, WS_Q = 480 * MiB, WS_KV = 672 * MiB, WS_KR = 928 * MiB;
constexpr size_t WS_G = 272 * MiB, WS_GATE = 560 * MiB, WS_OP = 688 * MiB, WS_OG = 784 * MiB;
constexpr size_t WS_END = 992 * MiB;
constexpr int LDS_BYTES = 147456;
constexpr int NPHASE = 20;
constexpr int DUP = 0;

typedef unsigned short bf16;
typedef short bf16x8 __attribute__((ext_vector_type(8)));
typedef short s16x4 __attribute__((ext_vector_type(4)));
typedef float f32x16 __attribute__((ext_vector_type(16)));
typedef float f32x4 __attribute__((ext_vector_type(4)));
typedef unsigned u32x4 __attribute__((ext_vector_type(4)));
typedef unsigned u32x2 __attribute__((ext_vector_type(2)));
#define LAS __attribute__((address_space(3)))

struct Args { const float* in[17]; float* out; unsigned char* ws; int ph_lo, ph_hi; };

__device__ __forceinline__ float bf2f(unsigned short h) { return __uint_as_float((unsigned)h << 16); }
__device__ __forceinline__ float bflo(unsigned w) { return __uint_as_float(w << 16); }
__device__ __forceinline__ float bfhi(unsigned w) { return __uint_as_float(w & 0xffff0000u); }
__device__ __forceinline__ unsigned cvtpk(float lo, float hi) { unsigned r; asm volatile("v_cvt_pk_bf16_f32 %0, %1, %2" : "=v"(r) : "v"(lo), "v"(hi)); return r; }
__device__ __forceinline__ unsigned short f2bf(float f) { return (unsigned short)(cvtpk(f, 0.f) & 0xffffu); }
__device__ __forceinline__ float wave_sum(float v) {
#pragma unroll
    for (int o = 1; o < 64; o <<= 1) v += __shfl_xor(v, o);
    return v;
}
__device__ __forceinline__ float silu_f(float g) { return g * __builtin_amdgcn_rcpf(1.f + __builtin_amdgcn_exp2f(g * -1.4426950408889634f)); }

__device__ __forceinline__ int dst_row(int map, int n0) {
    if (map == 0) return n0;
    if (map == 1) { const int part2 = n0 / 6144, r = n0 % 6144, br = r / 2048, h = (r % 2048) / 128, e = r % 128;
        return (h >> 2) * GN + (h & 3) * 1152 + (1 + part2) * 384 + br * 128 + e; }
    if (n0 < 6144) { const int br = n0 / 2048, h = (n0 % 2048) / 128, e = n0 % 128; return (h >> 2) * GN + (h & 3) * 1152 + br * 128 + e; }
    { const int c = n0 - 6144, h = c / 128, e = c % 128; return (h >> 2) * GN + GCOLS + (h & 3) * 128 + e; }
}
__device__ __forceinline__ void transpose_item(const float* W, int K, int N, const float* gain, bf16* WT, int map, LAS float* scr, int item, int lane) {
    const int nblk = N / 32, kb = item / nblk, nb = item % nblk, k0 = 64 * kb, n0 = 32 * nb;
    float wv[32];
#pragma unroll
    for (int i = 0; i < 32; ++i) wv[i] = __builtin_nontemporal_load(W + (size_t)(k0 + 2 * i + (lane >> 5)) * N + n0 + (lane & 31));
#pragma unroll
    for (int i = 0; i < 32; ++i) { const int kk = 2 * i + (lane >> 5); const float gsc = gain ? gain[k0 + kk] : 1.f;
        scr[kk * 33 + (lane & 31)] = wv[i] * gsc; }
    asm volatile("s_waitcnt lgkmcnt(0)" ::: "memory");
    const int c = lane & 7; const int d0 = dst_row(map, n0);
#pragma unroll
    for (int j = 0; j < 4; ++j) { const int n = (lane >> 3) + 8 * j; const LAS float* s = scr + (8 * c) * 33 + n;
        u32x4 o; o.x = cvtpk(s[0 * 33], s[1 * 33]); o.y = cvtpk(s[2 * 33], s[3 * 33]); o.z = cvtpk(s[4 * 33], s[5 * 33]); o.w = cvtpk(s[6 * 33], s[7 * 33]);
        *(u32x4*)(WT + (size_t)(d0 + n) * K + k0 + 8 * c) = o; }
    asm volatile("s_waitcnt lgkmcnt(0)" ::: "memory");
}
__device__ __forceinline__ void norm_row(const float* xrow, bf16* orow, int lane) {
    const f32x4* xr = (const f32x4*)xrow + lane;
    f32x4 v[8]; float s = 0.f;
#pragma unroll
    for (int j = 0; j < 8; ++j) { v[j] = xr[64 * j]; s += (v[j].x * v[j].x + v[j].y * v[j].y) + (v[j].z * v[j].z + v[j].w * v[j].w); }
    const float rstd = __builtin_amdgcn_rsqf(wave_sum(s) * (1.f / DM) + EPSN);
    u32x2* o8 = (u32x2*)orow + lane;
#pragma unroll
    for (int j = 0; j < 8; ++j) { u32x2 w; w.x = cvtpk(v[j].x * rstd, v[j].y * rstd); w.y = cvtpk(v[j].z * rstd, v[j].w * rstd); o8[64 * j] = w; }
}

template <bool NT_> __device__ __forceinline__ void norm_row2(const float* xa, bf16* oa, const float* xb, bf16* ob, int lane) {
    const f32x4* ra = (const f32x4*)xa + lane; const f32x4* rb = (const f32x4*)xb + lane;
    f32x4 va[8], vb[8]; float sa = 0.f, sb = 0.f;
#pragma unroll
    for (int j = 0; j < 8; ++j) { if (NT_) { va[j] = __builtin_nontemporal_load(ra + 64 * j); vb[j] = __builtin_nontemporal_load(rb + 64 * j); } else { va[j] = ra[64 * j]; vb[j] = rb[64 * j]; } }
#pragma unroll
    for (int j = 0; j < 8; ++j) { sa += (va[j].x * va[j].x + va[j].y * va[j].y) + (va[j].z * va[j].z + va[j].w * va[j].w);
                                  sb += (vb[j].x * vb[j].x + vb[j].y * vb[j].y) + (vb[j].z * vb[j].z + vb[j].w * vb[j].w); }
    const float rsa = __builtin_amdgcn_rsqf(wave_sum(sa) * (1.f / DM) + EPSN), rsb = __builtin_amdgcn_rsqf(wave_sum(sb) * (1.f / DM) + EPSN);
    u32x2* pa = (u32x2*)oa + lane; u32x2* pb = (u32x2*)ob + lane;
#pragma unroll
    for (int j = 0; j < 8; ++j) { u32x2 w; w.x = cvtpk(va[j].x * rsa, va[j].y * rsa); w.y = cvtpk(va[j].z * rsa, va[j].w * rsa); pa[64 * j] = w;
                                  u32x2 z; z.x = cvtpk(vb[j].x * rsb, vb[j].y * rsb); z.y = cvtpk(vb[j].z * rsb, vb[j].w * rsb); pb[64 * j] = z; }
}

template <bool NT_> __device__ __forceinline__ void norm_row4_nt(const float* x0, bf16* o0, size_t rstride, int lane) {
    f32x4 v[4][8]; float s[4] = {0.f, 0.f, 0.f, 0.f};
#pragma unroll
    for (int k = 0; k < 4; ++k) { const f32x4* r = (const f32x4*)(x0 + k * rstride) + lane;
#pragma unroll
        for (int j = 0; j < 8; ++j) v[k][j] = NT_ ? __builtin_nontemporal_load(r + 64 * j) : r[64 * j]; }
#pragma unroll
    for (int k = 0; k < 4; ++k)
#pragma unroll
        for (int j = 0; j < 8; ++j) s[k] += (v[k][j].x * v[k][j].x + v[k][j].y * v[k][j].y) + (v[k][j].z * v[k][j].z + v[k][j].w * v[k][j].w);
#pragma unroll
    for (int k = 0; k < 4; ++k) { const float rs = __builtin_amdgcn_rsqf(wave_sum(s[k]) * (1.f / DM) + EPSN); u32x2* p = (u32x2*)(o0 + k * rstride) + lane;
#pragma unroll
        for (int j = 0; j < 8; ++j) { u32x2 w; w.x = cvtpk(v[k][j].x * rs, v[k][j].y * rs); w.y = cvtpk(v[k][j].z * rs, v[k][j].w * rs); p[64 * j] = w; } }
}

__device__ __forceinline__ void sincos_pos(int s, int i, float& c, float& sn) {
    double inv = 1.0;
    if (i & 1) inv *= 0.7498942093324559; if (i & 2) inv *= 0.5623413251903491; if (i & 4) inv *= 0.31622776601683794; if (i & 8) inv *= 0.1; if (i & 16) inv *= 0.01;
    const double a = (double)s * inv;
    const double k = __builtin_rint(a * 0.15915494309189535);
    double r = __builtin_fma(-k, 6.283185307179586, a); r = __builtin_fma(-k, 2.4492935982947064e-16, r);
    const double r2 = r * r;
    double ps = -3.868170170630684e-23; ps = ps * r2 + 1.9572941063391263e-20; ps = ps * r2 - 8.22063524662433e-18; ps = ps * r2 + 2.8114572543455206e-15; ps = ps * r2 - 7.647163731819816e-13;
    ps = ps * r2 + 1.6059043836821613e-10; ps = ps * r2 - 2.505210838544172e-08; ps = ps * r2 + 2.7557319223985893e-06; ps = ps * r2 - 0.0001984126984126984; ps = ps * r2 + 0.008333333333333333;
    ps = ps * r2 - 0.16666666666666666; ps = ps * r2 + 1.0;
    double pc = -8.896791392450574e-22; pc = pc * r2 + 4.110317623312165e-19; pc = pc * r2 - 1.5619206968586225e-16; pc = pc * r2 + 4.779477332387385e-14; pc = pc * r2 - 1.1470745597729725e-11;
    pc = pc * r2 + 2.08767569878681e-09; pc = pc * r2 - 2.755731922398589e-07; pc = pc * r2 + 2.48015873015873e-05; pc = pc * r2 - 0.001388888888888889; pc = pc * r2 + 0.041666666666666664;
    pc = pc * r2 - 0.5; pc = pc * r2 + 1.0;
    sn = (float)(ps * r); c = (float)pc;
}
__device__ __forceinline__ void unpack8(const u32x4 a, float* f) {
#pragma unroll
    for (int j = 0; j < 4; ++j) { f[2 * j] = bflo(a[j]); f[2 * j + 1] = bfhi(a[j]); }
}
__device__ __forceinline__ u32x4 pack8f(const float* f) { u32x4 w; w.x = cvtpk(f[0], f[1]); w.y = cvtpk(f[2], f[3]); w.z = cvtpk(f[4], f[5]); w.w = cvtpk(f[6], f[7]); return w; }
__device__ __forceinline__ void qknorm_phase(unsigned char* ws, const float* gq, const float* gk, int gw, int ngw, int lane) {
    bf16* U = (bf16*)(ws + WS_U); bf16* Q = (bf16*)(ws + WS_Q); bf16* KV = (bf16*)(ws + WS_KV);
    const float* COS = (const float*)(ws + WS_ROPE); const float* SIN = COS + SEQ * 32;
    const int h = lane >> 2, part = lane & 3;
    for (int t = gw; t < NTOK; t += ngw) {
        const int s = t & (SEQ - 1);
        const float* gqp = gq; const float* gkp = gk; asm volatile("" : "+s"(gqp), "+s"(gkp));
        char* ub = (char*)(U + (size_t)t * UCOLS); char* qb = (char*)(Q + (size_t)t * QCOLS); char* kb = (char*)(KV + (size_t)t * KVCOLS);
        const unsigned oq = (unsigned)(h * 192 + part * 32) * 2u, oq1 = (unsigned)(h * 192 + 128 + part * 8) * 2u, ok = (unsigned)(h * 256 + part * 64) * 2u;
        const unsigned opeo = (unsigned)(1024 + part * 8) * 2u, okr = (unsigned)(h * 64 + part * 8) * 2u;
        bf16* urow = (bf16*)ub; bf16* qp = (bf16*)qb + h * 192; bf16* kp = (bf16*)(kb + ok);
        const u32x4 cqv = *(const u32x4*)(ub + 16u * (unsigned)lane);
        u32x4 qn[4];
#pragma unroll
        for (int i = 0; i < 4; ++i) qn[i] = *(const u32x4*)(qb + oq + 16u * i);
        const u32x4 qr1 = *(const u32x4*)(qb + oq1), qr2 = *(const u32x4*)(qb + oq1 + 64u);
        float cs[8], sn[8];
        { const char* cb_ = (const char*)(COS + s * 32); const char* sb_ = (const char*)(SIN + s * 32); unsigned ot = (unsigned)part * 32u; asm volatile("" : "+v"(ot));
          const f32x4 a = *(const f32x4*)(cb_ + ot), b = *(const f32x4*)(cb_ + ot + 16u), c = *(const f32x4*)(sb_ + ot), d = *(const f32x4*)(sb_ + ot + 16u);
#pragma unroll
          for (int j = 0; j < 4; ++j) { cs[j] = a[j]; cs[4 + j] = b[j]; sn[j] = c[j]; sn[4 + j] = d[j]; } }
        float rstd_q;
        { float f[8]; unpack8(cqv, f); float q = 0.f;
#pragma unroll
          for (int j = 0; j < 8; ++j) q += f[j] * f[j];
          rstd_q = __builtin_amdgcn_rsqf(wave_sum(q) * (1.f / 512.f) + EPSN); }
        { float y[32], r1[8], r2[8]; float ssq = 0.f;
#pragma unroll
          for (int i = 0; i < 4; ++i) unpack8(qn[i], y + 8 * i);
          unpack8(qr1, r1); unpack8(qr2, r2);
#pragma unroll
          for (int j = 0; j < 32; ++j) ssq += y[j] * y[j];
#pragma unroll
          for (int j = 0; j < 8; ++j) ssq += r1[j] * r1[j] + r2[j] * r2[j];
          ssq += __shfl_xor(ssq, 1); ssq += __shfl_xor(ssq, 2);
          const float scq = rstd_q * (__builtin_amdgcn_rsqf(ssq * rstd_q * rstd_q * (1.f / 192.f) + EPSN)) * QSCALE_A;
#pragma unroll
          for (int i = 0; i < 8; ++i) { const f32x4 g = *(const f32x4*)(gqp + part * 32 + 4 * i);
#pragma unroll
              for (int j = 0; j < 4; ++j) y[4 * i + j] *= scq * g[j]; }
#pragma unroll
          for (int i = 0; i < 4; ++i) *(u32x4*)(qb + oq + 16u * i) = pack8f(y + 8 * i);
          float o1[8], o2[8];
#pragma unroll
          for (int i = 0; i < 2; ++i) { const f32x4 g1 = *(const f32x4*)(gqp + 128 + part * 8 + 4 * i), g2 = *(const f32x4*)(gqp + 160 + part * 8 + 4 * i);
#pragma unroll
              for (int j = 0; j < 4; ++j) { const int e = 4 * i + j; const float y1 = r1[e] * scq * g1[j], y2 = r2[e] * scq * g2[j];
                  o1[e] = y1 * cs[e] - y2 * sn[e]; o2[e] = y2 * cs[e] + y1 * sn[e]; } }
          *(u32x4*)(qb + oq1) = pack8f(o1); *(u32x4*)(qb + oq1 + 64u) = pack8f(o2); }
        __builtin_amdgcn_sched_barrier(0);
        const u32x4 ckvv = *(const u32x4*)(ub + 1024u + 16u * (unsigned)lane);
        const u32x4 pe1 = *(const u32x4*)(ub + opeo), pe2 = *(const u32x4*)(ub + opeo + 64u);
        u32x4 kvv[8];
#pragma unroll
        for (int i = 0; i < 8; ++i) kvv[i] = *(const u32x4*)(kb + ok + 16u * i);
        float rstd_kv, ssq_pe;
        { float f[8]; unpack8(ckvv, f); float q = 0.f;
#pragma unroll
          for (int j = 0; j < 8; ++j) q += f[j] * f[j];
          rstd_kv = __builtin_amdgcn_rsqf(wave_sum(q) * (1.f / 512.f) + EPSN); }
        float x1[8], x2[8]; unpack8(pe1, x1); unpack8(pe2, x2);
        { float q = 0.f;
#pragma unroll
          for (int j = 0; j < 8; ++j) q += x1[j] * x1[j] + x2[j] * x2[j];
          q += __shfl_xor(q, 1); q += __shfl_xor(q, 2); ssq_pe = q; }
        { float ssq = 0.f;
#pragma unroll
          for (int i = 0; i < 8; ++i) { float f[8]; unpack8(kvv[i], f);
#pragma unroll
              for (int j = 0; j < 8; ++j) ssq += f[j] * f[j]; }
          ssq = part < 2 ? ssq : 0.f;
          ssq += __shfl_xor(ssq, 1); ssq += __shfl_xor(ssq, 2);
          const float rk = __builtin_amdgcn_rsqf((ssq * rstd_kv * rstd_kv + ssq_pe) * (1.f / 192.f) + EPSN);
          const float sck = part < 2 ? rstd_kv * rk : rstd_kv;
#pragma unroll
          for (int i = 0; i < 8; ++i) { float f[8]; unpack8(kvv[i], f);
              f32x4 g0 = *(const f32x4*)(gkp + (part & 1) * 64 + 8 * i), g1 = *(const f32x4*)(gkp + (part & 1) * 64 + 8 * i + 4);
              if (part >= 2) { g0 = (f32x4){1.f, 1.f, 1.f, 1.f}; g1 = g0; }
#pragma unroll
              for (int j = 0; j < 4; ++j) { f[j] *= sck * g0[j]; f[4 + j] *= sck * g1[j]; }
              *(u32x4*)(kb + ok + 16u * i) = pack8f(f); }
          float o1[8], o2[8];
#pragma unroll
          for (int i = 0; i < 2; ++i) { const f32x4 g1 = *(const f32x4*)(gkp + 128 + part * 8 + 4 * i), g2 = *(const f32x4*)(gkp + 160 + part * 8 + 4 * i);
#pragma unroll
              for (int j = 0; j < 4; ++j) { const int e = 4 * i + j; const float y1 = x1[e] * rk * g1[j], y2 = x2[e] * rk * g2[j];
                  o1[e] = y1 * cs[e] - y2 * sn[e]; o2[e] = y2 * cs[e] + y1 * sn[e]; } }
          *(u32x4*)(ub + okr) = pack8f(o1); *(u32x4*)(ub + okr + 64u) = pack8f(o2); }
    }
}

#define SBAR() __builtin_amdgcn_sched_barrier(0)
__device__ __forceinline__ int v_st(int k, int c) { const int kk = (k & ~0xC) | ((k & 4) << 1) | ((k & 8) >> 1); return ((kk >> 3) * 4 + (c >> 5)) * 512 + ((kk & 7) * 32 + (c & 31)) * 2; }
__device__ __forceinline__ int v_rd_base(int lane) { return ((lane & 3) << 3) | (((lane >> 2) & 3) << 6) | (((lane >> 4) & 1) << 5) | (((lane >> 5) & 1) << 8); }
__device__ __forceinline__ int crow(int r, int hi) { return (r & 3) + 8 * (r >> 2) + 4 * hi; }
#define PK4(P, B_, OUT) do { unsigned a0 = cvtpk(P[B_+0], P[B_+1]), a1 = cvtpk(P[B_+2], P[B_+3]);                          \
        unsigned b0 = cvtpk(P[B_+4], P[B_+5]), b1 = cvtpk(P[B_+6], P[B_+7]);                                             \
        auto r0 = __builtin_amdgcn_permlane32_swap(a0, b0, false, false); auto r1 = __builtin_amdgcn_permlane32_swap(a1, b1, false, false); \
        u32x4 w = {r0[0], r1[0], r0[1], r1[1]}; OUT = *reinterpret_cast<bf16x8*>(&w); } while (0)
#define TRRD(dst, off) asm volatile("ds_read_b64_tr_b16 %0, %1 offset:%2" : "=&v"(dst) : "v"(vb0), "i"(off) : "memory")

namespace mla {
constexpr int SHM_V = 16384, SHM_K = 24576, OFF_K = 3 * SHM_V, OFF_WS = OFF_K + 3 * SHM_K;
__device__ __forceinline__ int kswz(int row, int colB) { return row * 384 + (colB ^ (((row >> 1) & 7) << 4)); }
#define MBAR() asm volatile("s_waitcnt lgkmcnt(0)\n\ts_barrier" ::: "memory")
__device__ __forceinline__ void qkt(f32x16& p0, f32x16& p1, const char* kbuf, const int* koff, const bf16x8* qr) {
    p0 = f32x16{}; p1 = f32x16{};
    int ka[4];
#pragma unroll
    for (int dd = 0; dd < 4; ++dd) ka[dd] = (int)(uintptr_t)kbuf + koff[dd];
    bf16x8 X0, X1, Y0, Y1, Z0, Z1;
#define KRD(S, s_) asm volatile("ds_read_b128 %0, %2 offset:%3\n\tds_read_b128 %1, %2 offset:%4" : "=&v"(S##0), "=&v"(S##1) : "v"(ka[(s_) & 3]), "i"(((s_) >> 2) * 128), "i"(((s_) >> 2) * 128 + 12288) : "memory")
#define KMM(S, s_) do { p0 = __builtin_amdgcn_mfma_f32_32x32x16_bf16(S##0, qr[s_], p0, 0, 0, 0); p1 = __builtin_amdgcn_mfma_f32_32x32x16_bf16(S##1, qr[s_], p1, 0, 0, 0); } while (0)
    KRD(X, 0); KRD(Y, 1);
    KRD(Z, 2); asm volatile("s_waitcnt lgkmcnt(4)" ::: "memory"); SBAR(); KMM(X, 0); SBAR();
    KRD(X, 3); asm volatile("s_waitcnt lgkmcnt(4)" ::: "memory"); SBAR(); KMM(Y, 1); SBAR();
    KRD(Y, 4); asm volatile("s_waitcnt lgkmcnt(4)" ::: "memory"); SBAR(); KMM(Z, 2); SBAR();
    KRD(Z, 5); asm volatile("s_waitcnt lgkmcnt(4)" ::: "memory"); SBAR(); KMM(X, 3); SBAR();
    KRD(X, 6); asm volatile("s_waitcnt lgkmcnt(4)" ::: "memory"); SBAR(); KMM(Y, 4); SBAR();
    KRD(Y, 7); asm volatile("s_waitcnt lgkmcnt(4)" ::: "memory"); SBAR(); KMM(Z, 5); SBAR();
    KRD(Z, 8); asm volatile("s_waitcnt lgkmcnt(4)" ::: "memory"); SBAR(); KMM(X, 6); SBAR();
    KRD(X, 9); asm volatile("s_waitcnt lgkmcnt(4)" ::: "memory"); SBAR(); KMM(Y, 7); SBAR();
    KRD(Y, 10); asm volatile("s_waitcnt lgkmcnt(4)" ::: "memory"); SBAR(); KMM(Z, 8); SBAR();
    KRD(Z, 11); asm volatile("s_waitcnt lgkmcnt(4)" ::: "memory"); SBAR(); KMM(X, 9); SBAR();
    asm volatile("s_waitcnt lgkmcnt(2)" ::: "memory"); SBAR(); KMM(Y, 10); SBAR();
    asm volatile("s_waitcnt lgkmcnt(0)" ::: "memory"); SBAR(); KMM(Z, 11); SBAR();
#undef KRD
#undef KMM
}
__device__ __forceinline__ void pv_tile(f32x16* o, int vb0, bf16x8 pa0, bf16x8 pa1, bf16x8 pa2, bf16x8 pa3) {
    s16x4 A0, A1, A2, A3, A4, A5, A6, A7, B0, B1, B2, B3, B4, B5, B6, B7;
#define RD8(S, d0) do { constexpr int b_ = (d0) * 512; TRRD(S##0, b_); TRRD(S##1, b_ + 2048); TRRD(S##2, b_ + 4096); TRRD(S##3, b_ + 6144); \
        TRRD(S##4, b_ + 8192); TRRD(S##5, b_ + 10240); TRRD(S##6, b_ + 12288); TRRD(S##7, b_ + 14336); } while (0)
#define MM4(S, d0) do { \
        o[d0] = __builtin_amdgcn_mfma_f32_32x32x16_bf16(pa0, (bf16x8){S##0[0], S##0[1], S##0[2], S##0[3], S##1[0], S##1[1], S##1[2], S##1[3]}, o[d0], 0, 0, 0); \
        o[d0] = __builtin_amdgcn_mfma_f32_32x32x16_bf16(pa1, (bf16x8){S##2[0], S##2[1], S##2[2], S##2[3], S##3[0], S##3[1], S##3[2], S##3[3]}, o[d0], 0, 0, 0); \
        o[d0] = __builtin_amdgcn_mfma_f32_32x32x16_bf16(pa2, (bf16x8){S##4[0], S##4[1], S##4[2], S##4[3], S##5[0], S##5[1], S##5[2], S##5[3]}, o[d0], 0, 0, 0); \
        o[d0] = __builtin_amdgcn_mfma_f32_32x32x16_bf16(pa3, (bf16x8){S##6[0], S##6[1], S##6[2], S##6[3], S##7[0], S##7[1], S##7[2], S##7[3]}, o[d0], 0, 0, 0); } while (0)
    RD8(A, 0);
    RD8(B, 1); asm volatile("s_waitcnt lgkmcnt(8)" ::: "memory"); SBAR(); MM4(A, 0); SBAR();
    RD8(A, 2); asm volatile("s_waitcnt lgkmcnt(8)" ::: "memory"); SBAR(); MM4(B, 1); SBAR();
    RD8(B, 3); asm volatile("s_waitcnt lgkmcnt(8)" ::: "memory"); SBAR(); MM4(A, 2); SBAR();
    asm volatile("s_waitcnt lgkmcnt(0)" ::: "memory"); SBAR(); MM4(B, 3);
#undef RD8
#undef MM4
}
__device__ __forceinline__ void block(int b, int h, int qb, unsigned char* ws, char* lds, int grp, int wid) {
    const bf16* Q = (const bf16*)(ws + WS_Q); const bf16* KV = (const bf16*)(ws + WS_KV); const bf16* KR = (const bf16*)(ws + WS_KR); const bf16* U = (const bf16*)(ws + WS_U); bf16* OG = (bf16*)(ws + WS_XN);
    const int lane = lane_id(), tid = wid * 64 + lane, r32 = lane & 31, hi = lane >> 5;
    const size_t tb = (size_t)b * SEQ;
    const int qlo = qb * 256 + wid * 32;
    char* V_lds = lds; char* K_lds = lds + OFF_K;
    float* wsf = (float*)(lds + OFF_WS) + wid * 64; float* li_l = wsf; float* al_l = wsf + 32;
    bf16x8 qr[12];
    { const bf16* qp = Q + (tb + qlo + r32) * QCOLS + h * 192 + hi * 8;
#pragma unroll
      for (int d0 = 0; d0 < 12; ++d0) qr[d0] = *(const bf16x8*)(qp + d0 * 16); }
    const int NT = (qb + 1) * 4;
    unsigned ko[3], ki[3], vo[2];
#pragma unroll
    for (int j = 0; j < 3; ++j) { const int pos = 1024 * (3 * wid + j) + 16 * lane, row = pos / 384, slot = (pos - row * 384) >> 4;
        const int ch = (slot & ~7) | ((slot & 7) ^ ((row >> 1) & 7));
        if (ch < 16) { ko[j] = (unsigned)WS_KV + (unsigned)((tb + row) * KVCOLS + h * 256 + ch * 8) * 2u; ki[j] = 64u * KVCOLS * 2u; }
        else { ko[j] = (unsigned)WS_U + (unsigned)((tb + row) * UCOLS + h * 64 + (ch - 16) * 8) * 2u; ki[j] = 64u * UCOLS * 2u; } }
#pragma unroll
    for (int j = 0; j < 2; ++j) { const int pos = 1024 * (2 * wid + j) + 16 * lane, st = pos >> 9, kk = (st >> 2) * 8 + ((pos & 511) >> 6), c = (st & 3) * 32 + ((pos & 63) >> 4) * 8;
        const int k = (kk & ~0xC) | ((kk & 4) << 1) | ((kk & 8) >> 1);
        vo[j] = (unsigned)WS_KV + (unsigned)((tb + k) * KVCOLS + h * 256 + 128 + c) * 2u; }
    const int vb0 = (int)(uintptr_t)V_lds + v_rd_base(lane);
    int koff[4];
#pragma unroll
    for (int dd = 0; dd < 4; ++dd) koff[dd] = kswz(r32, (dd * 16 + hi * 8) * 2);
    LAS unsigned char* ldsK = (LAS unsigned char*)K_lds + wid * 3072; LAS unsigned char* ldsV = (LAS unsigned char*)V_lds + wid * 2048;
#define DMAK(bo_) do { _Pragma("unroll") for (int j_ = 0; j_ < 3; ++j_) { \
        __builtin_amdgcn_global_load_lds((const unsigned*)(ws + ko[j_]), (LAS unsigned*)(ldsK + (bo_) + j_ * 1024), 16, 0, 0); ko[j_] += ki[j_]; } } while (0)
#define DMAV(bo_) do { _Pragma("unroll") for (int j_ = 0; j_ < 2; ++j_) { \
        __builtin_amdgcn_global_load_lds((const unsigned*)(ws + vo[j_]), (LAS unsigned*)(ldsV + (bo_) + j_ * 1024), 16, 0, 0); vo[j_] += 64u * KVCOLS * 2u; } } while (0)
#define VMW0() asm volatile("s_waitcnt vmcnt(0)" ::: "memory")
    float m_reg = -1e30f, l_reg = 0.f; f32x16 o[4] = {};
    DMAK(0); DMAV(0); DMAK(SHM_K);
    VMW0(); MBAR();
    if (grp == 1) MBAR();
    int kcur = 0, kp2 = 2 * SHM_K;
    int vcur = 0, vnext = SHM_V;
    bf16x8 pa0, pa1, pa2, pa3; f32x16 p0, p1;
#define VALU_HALF(t) do { \
        SBAR(); if ((t) + 2 < NT) DMAK(kp2); if ((t) + 1 < NT) DMAV(vnext); SBAR(); \
        if (64 * (t) + 63 > qlo) { const int dq = qlo + r32 - 4 * hi - 64 * (t); const float NEG = -__builtin_inff(); \
            _Pragma("unroll") for (int r = 0; r < 16; ++r) { const int c = (r & 3) + 8 * (r >> 2); if (dq - c < 0) p0[r] = NEG; if (dq - c - 32 < 0) p1[r] = NEG; } } \
        float pmax = p0[0]; \
        _Pragma("unroll") for (int r = 1; r < 16; ++r) pmax = fmaxf(pmax, p0[r]); \
        _Pragma("unroll") for (int r = 0; r < 16; ++r) pmax = fmaxf(pmax, p1[r]); \
        { auto rr = __builtin_amdgcn_permlane32_swap(__float_as_uint(pmax), __float_as_uint(pmax), false, false); pmax = fmaxf(__uint_as_float(rr[0]), __uint_as_float(rr[1])); } \
          \
        const bool grow_ = __any(pmax > m_reg + 8.0f); \
        const float mn = grow_ ? fmaxf(m_reg, pmax) : m_reg; const float alpha = grow_ ? __builtin_amdgcn_exp2f(m_reg - mn) : 1.0f; m_reg = mn; \
        float ps = 0.f; \
        _Pragma("unroll") for (int r = 0; r < 16; ++r) { p0[r] = __builtin_amdgcn_exp2f(p0[r] - mn); ps += p0[r]; } \
        _Pragma("unroll") for (int r = 0; r < 16; ++r) { p1[r] = __builtin_amdgcn_exp2f(p1[r] - mn); ps += p1[r]; } \
        { auto rr = __builtin_amdgcn_permlane32_swap(__float_as_uint(ps), __float_as_uint(ps), false, false); ps = __uint_as_float(rr[0]) + __uint_as_float(rr[1]); } \
        l_reg = l_reg * alpha + ps; \
        PK4(p0, 0, pa0); PK4(p0, 8, pa1); PK4(p1, 0, pa2); PK4(p1, 8, pa3); \
        if (grow_) { if (hi == 0) al_l[r32] = alpha; asm volatile("s_waitcnt lgkmcnt(0)" ::: "memory"); \
            _Pragma("unroll") for (int d_ = 0; d_ < 4; ++d_) _Pragma("unroll") for (int r = 0; r < 16; ++r) o[d_][r] *= al_l[crow(r, hi)]; } \
        MBAR(); } while (0)
    qkt(p0, p1, K_lds + kcur, koff, qr);
    VMW0(); MBAR();
    for (int t = 0; t + 1 < NT; ++t) {
        VALU_HALF(t);
        kcur = (kcur == 2 * SHM_K) ? 0 : kcur + SHM_K; kp2 = (kp2 == 2 * SHM_K) ? 0 : kp2 + SHM_K;
        pv_tile(o, vb0 + vcur, pa0, pa1, pa2, pa3);
        qkt(p0, p1, K_lds + kcur, koff, qr);
        VMW0(); MBAR();
        vcur = vnext; vnext = (vnext == 2 * SHM_V) ? 0 : vnext + SHM_V;
    }
    VALU_HALF(NT - 1);
    pv_tile(o, vb0 + vcur, pa0, pa1, pa2, pa3);
    MBAR();
    if (grp == 0) MBAR();
#undef VALU_HALF
#undef DMAK
#undef DMAV
#undef VMW0
    { int le = lane; asm volatile("" : "+v"(le)); const int r32e = le & 31, hie = le >> 5;
      if (hie == 0) li_l[r32e] = l_reg; asm volatile("s_waitcnt lgkmcnt(0)" ::: "memory");
#pragma unroll
      for (int r = 0; r < 16; ++r) { const size_t row = tb + qlo + crow(r, hie); const float rl = __builtin_amdgcn_rcpf(li_l[crow(r, hie)]);
#pragma unroll
        for (int d0 = 0; d0 < 4; ++d0) { const int col = h * 128 + d0 * 32 + r32e;
            const float g = bf2f(U[row * UCOLS + 1088 + col]);
            OG[row * DM + col] = f2bf(o[d0][r] * rl * silu_f(g)); } } }
    MBAR();
}
__device__ __forceinline__ void phase(unsigned char* ws, char* lds, int wid) {
    const int G = gridDim.x, bx = blockIdx.x; const int vcu = (G % 8 == 0) ? (bx % 8) * (G / 8) + bx / 8 : bx;
    int grp;
    { unsigned* cnt = (unsigned*)(lds + OFF_WS + 2048);
      const int lane0 = lane_id();
      if (wid == 0 && lane0 < 4) cnt[lane0] = 0u;
      __syncthreads();
      const unsigned simd = (unsigned)__builtin_amdgcn_s_getreg((1 << 11) | (4 << 6) | 4) & 3u;
      unsigned g = 0u; if (lane0 == 0) g = atomicAdd(&cnt[simd], 1u);
      grp = (int)(__builtin_amdgcn_readfirstlane(g) & 1u);
      __syncthreads(); }
    for (int L = vcu; L < 1024; L += G) { const int bh = L >> 5, x = L & 31;
        for (int pass = 0; pass < 2; ++pass) block(bh >> 4, bh & 15, pass ? x : 63 - x, ws, lds, grp, wid);     }
}
}

namespace dil {
__device__ __forceinline__ void wave_item(int w, int gi, const bf16* Gb, const float* gqn, const float* gkn, bf16* OP, float* LSE, char* wlds, int lane) {
    const int r32 = lane & 31, hi = lane >> 5;
    const int sb = w & 511, grp = w >> 9, br = grp % 3, hh = (grp / 3) & 3, b = grp / 12;
    const int dsh = 2 * br, d = 1 << dsh;
    const int nblk = 512 >> dsh, res = sb / nblk, blk = sb % nblk, n0 = blk * 32;
    const size_t tb = (size_t)b * SEQ;
    const int hcol = hh * 1152 + br * 128;
    float* rk_l = (float*)(wlds + 8192); float* al_l = rk_l + 32; float* li_l = al_l + 32;
    const int vb0 = (int)(uintptr_t)wlds + v_rd_base(lane);
    bf16x8 qr[8];
    { const bf16* qp = Gb + (tb + (size_t)(n0 + r32) * d + res) * GCOLS + hcol + hi * 8;
#pragma unroll
      for (int d0 = 0; d0 < 8; ++d0) qr[d0] = *(const bf16x8*)(qp + d0 * 16); }
    const int hg = gi * 4 + hh;
    const float ab = exp2f(-0.5f * (float)(hg + 1)) * (float)d * LOG2E;
    float m_reg = -1e30f, l_reg = 0.f; f32x16 o[4] = {};
    const int jfirst = n0 >= 128 ? 0 : ((128 - n0) >> 5);
    const bf16* kcol = Gb + hcol + 384 + hi * 8; const bf16* vcol = Gb + hcol + 768 + (lane & 15) * 8;
    bf16x8 kf[8]; u32x4 vv[8];
#define DIL_LOAD(j_) do { const int kb_ = n0 - 128 + 32 * (j_); \
        { int nk = kb_ + r32; nk = nk < 0 ? 0 : nk; const bf16* kp = kcol + (tb + (size_t)nk * d + res) * GCOLS; \
          _Pragma("unroll") for (int d0 = 0; d0 < 8; ++d0) kf[d0] = *(const bf16x8*)(kp + d0 * 16); } \
        _Pragma("unroll") for (int i = 0; i < 8; ++i) { int nk = kb_ + (lane >> 4) + 4 * i; nk = nk < 0 ? 0 : nk; \
            vv[i] = *(const u32x4*)(vcol + (tb + (size_t)nk * d + res) * GCOLS); } } while (0)
    DIL_LOAD(jfirst);
    for (int j = jfirst; j < 5; ++j) {
        const int kbase = n0 - 128 + 32 * j;
#pragma unroll
        for (int i = 0; i < 8; ++i) *(u32x4*)(wlds + v_st((lane >> 4) + 4 * i, (lane & 15) * 8)) = vv[i];
        f32x16 p0 = f32x16{};
#pragma unroll
        for (int d0 = 0; d0 < 8; ++d0) p0 = __builtin_amdgcn_mfma_f32_32x32x16_bf16(kf[d0], qr[d0], p0, 0, 0, 0);
        SBAR();
        if (j + 1 < 5) DIL_LOAD(j + 1);
        SBAR();
        asm volatile("s_waitcnt lgkmcnt(0)" ::: "memory");
        const float NEG = -__builtin_inff();
        float pmax = NEG;
#pragma unroll
        for (int r = 0; r < 16; ++r) { const int kc = crow(r, hi); const int nk = kbase + kc; const int rel = n0 + r32 - nk;
            float sv = p0[r] - ab * (float)rel;
            if (rel < 0 || rel > 128 || nk < 0) sv = NEG;
            p0[r] = sv; pmax = fmaxf(pmax, sv); }
        { auto rr = __builtin_amdgcn_permlane32_swap(__float_as_uint(pmax), __float_as_uint(pmax), false, false); pmax = fmaxf(__uint_as_float(rr[0]), __uint_as_float(rr[1])); }
        const float mn = fmaxf(m_reg, pmax); const float alpha = __builtin_amdgcn_exp2f(m_reg - mn); m_reg = mn;
        float ps = 0.f;
#pragma unroll
        for (int r = 0; r < 16; ++r) { p0[r] = __builtin_amdgcn_exp2f(p0[r] - mn); ps += p0[r]; }
        { auto rr = __builtin_amdgcn_permlane32_swap(__float_as_uint(ps), __float_as_uint(ps), false, false); ps = __uint_as_float(rr[0]) + __uint_as_float(rr[1]); }
        l_reg = l_reg * alpha + ps;
        bf16x8 pa0, pa1; PK4(p0, 0, pa0); PK4(p0, 8, pa1);
        if (__any(alpha < 1.f)) { if (hi == 0) al_l[r32] = alpha; asm volatile("s_waitcnt lgkmcnt(0)" ::: "memory");
#pragma unroll
            for (int d_ = 0; d_ < 4; ++d_)
#pragma unroll
                for (int r = 0; r < 16; ++r) o[d_][r] *= al_l[crow(r, hi)]; }
#define PV2(d0) do { s16x4 l0, l1, h0, h1; constexpr int b_ = (d0) * 512; \
        TRRD(l0, b_); TRRD(h0, b_ + 2048); TRRD(l1, b_ + 4096); TRRD(h1, b_ + 6144); \
        asm volatile("s_waitcnt lgkmcnt(0)" ::: "memory"); SBAR(); \
        o[d0] = __builtin_amdgcn_mfma_f32_32x32x16_bf16(pa0, (bf16x8){l0[0], l0[1], l0[2], l0[3], h0[0], h0[1], h0[2], h0[3]}, o[d0], 0, 0, 0);   \
        o[d0] = __builtin_amdgcn_mfma_f32_32x32x16_bf16(pa1, (bf16x8){l1[0], l1[1], l1[2], l1[3], h1[0], h1[1], h1[2], h1[3]}, o[d0], 0, 0, 0); } while (0)
        PV2(0); PV2(1); PV2(2); PV2(3);
#undef PV2
    }
#undef DIL_LOAD
    if (hi == 0) { li_l[r32] = l_reg; LSE[((size_t)br * NTOK + tb + (size_t)(n0 + r32) * d + res) * 4 + hh] = m_reg + __builtin_amdgcn_logf(l_reg); }
    asm volatile("s_waitcnt lgkmcnt(0)" ::: "memory");
    bf16* op = OP + (size_t)br * NTOK * 512;
    float rl[16];
#pragma unroll
    for (int r = 0; r < 16; ++r) rl[r] = __builtin_amdgcn_rcpf(li_l[crow(r, hi)]);
    asm volatile("s_waitcnt lgkmcnt(0)" ::: "memory");
#pragma unroll
    for (int r = 0; r < 16; ++r) { const int qc = crow(r, hi);
#pragma unroll
        for (int d0 = 0; d0 < 4; ++d0) *(unsigned short*)(wlds + qc * 272 + (d0 * 32 + r32) * 2) = f2bf(o[d0][r] * rl[r]); }
    asm volatile("s_waitcnt lgkmcnt(0)" ::: "memory");
#pragma unroll
    for (int i = 0; i < 8; ++i) { const int q = (lane >> 4) + 4 * i; const u32x4 v = *(const u32x4*)(wlds + q * 272 + (lane & 15) * 16);
        const size_t row = tb + (size_t)(n0 + q) * d + res; *(u32x4*)(op + row * 512 + hh * 128 + (lane & 15) * 8) = v; }
    asm volatile("s_waitcnt lgkmcnt(0)" ::: "memory");
}
}

__global__ void __launch_bounds__(512, 2) yoco_fwd(Args args) {
    extern __shared__ __attribute__((aligned(16))) unsigned char lds[];
    cg::grid_group grid = cg::this_grid();
    const int wave = __builtin_amdgcn_readfirstlane((int)threadIdx.x >> 6);
#define lane lane_id()
    const int G = gridDim.x; const int gw = blockIdx.x * 8 + wave, ngw = G * 8;
    unsigned char* ws = args.ws;
    const int lo = args.ph_lo, hi = args.ph_hi;
#define IN(k) (lo <= (k) && (k) < hi)
#define SEAM(k) do { if ((k) + 1 < hi) grid.sync(); } while (0)
    if (IN(0)) {
      for (int rep = 0; rep < (DUP == 100 ? 2 : 1); ++rep) {
        LAS float* scr = (LAS float*)((LAS unsigned char*)lds + wave * 16384);
        int base = 0;
#define TR_MAT(Wp, Kc, Nc, Gp, Tp, Mp) do { const int ni = ((Kc) / 64) * ((Nc) / 32); int first = (gw - base) % ngw; if (first < 0) first += ngw; \
            for (int it = first; it < ni; it += ngw) transpose_item((Wp), (Kc), (Nc), (Gp), (Tp), (Mp), scr, it, lane); base += ni; } while (0)
        TR_MAT(args.in[2], 2048, 3136, args.in[1], (bf16*)(ws + WS_WAIN), 0);
        TR_MAT(args.in[4], 512, 3072, args.in[3], (bf16*)(ws + WS_WQUP), 0);
        TR_MAT(args.in[6], 512, 4096, args.in[5], (bf16*)(ws + WS_WKVUP), 0);
        TR_MAT(args.in[9], 2048, 2048, (const float*)nullptr, (bf16*)(ws + WS_WAO), 0);
        TR_MAT(args.in[11], 2048, 12288, args.in[10], (bf16*)(ws + WS_WBALL), 1);
        TR_MAT(args.in[14], 2048, 8192, args.in[13], (bf16*)(ws + WS_WBALL), 2);
        TR_MAT(args.in[16], 2048, 2048, (const float*)nullptr, (bf16*)(ws + WS_WBO), 0);
#undef TR_MAT
        if (NTOK % (4 * ngw) == 0) { for (int m = gw; m < NTOK; m += 4 * ngw) norm_row4_nt<true>(args.in[0] + (size_t)m * DM, (bf16*)(ws + WS_XN) + (size_t)m * DM, (size_t)ngw * DM, lane); }
        else { for (int m = gw; m < NTOK; m += ngw) norm_row(args.in[0] + (size_t)m * DM, (bf16*)(ws + WS_XN) + (size_t)m * DM, lane); }
        { float* COS = (float*)(ws + WS_ROPE); float* SIN = COS + SEQ * 32;
          for (int idx = gw * 64 + lane; idx < SEQ * 32; idx += ngw * 64) { float c, sn; sincos_pos(idx >> 5, idx & 31, c, sn); COS[idx] = c; SIN[idx] = sn; } }
      }
        SEAM(0);
    }
    if (IN(1)) {
        const pg8::Gemm g{(bf16*)(ws + WS_XN), (bf16*)(ws + WS_WAIN), NTOK, UCOLS, 2048, 2048};
        const pg8::EpiSt E{(bf16*)(ws + WS_U), UCOLS, 1 << 30, nullptr, 0, 0};
        pg8::StaticOrder S; S.init(g.M, g.N, G, (int)blockIdx.x);
#ifndef SK_G1
        for (int rep = 0; rep < (DUP == 1 ? 2 : 1); ++rep)
        pg8::gemm_phase<pg8::EpiSt, pg8::StaticOrder, true, true, 2048, 2048>((LAS unsigned char*)lds, g, S, E, wave);
#endif
        SEAM(1);
    }
    if (IN(2)) {
        for (int cj = 0; cj < (DUP == 2 ? 4 : 2); ++cj) { const int ci = cj & 1;
            const pg8::Gemm g{(bf16*)(ws + WS_U) + (ci ? 512 : 0), (bf16*)(ws + (ci ? WS_WKVUP : WS_WQUP)), NTOK, ci ? KVCOLS : QCOLS, 512, UCOLS};
            const pg8::EpiSt E{(bf16*)(ws + (ci ? WS_KV : WS_Q)), ci ? KVCOLS : QCOLS, 1 << 30, nullptr, 0, 0};
            pg8::StaticOrder S; S.init(g.M, g.N, G, (int)blockIdx.x);
#ifndef SK_G1
            pg8::gemm_phase<pg8::EpiSt, pg8::StaticOrder, true, true, 512, UCOLS>((LAS unsigned char*)lds, g, S, E, wave);
#endif
        }
        SEAM(2);
    }
    if (IN(3)) {
#ifndef SK_QKN
        { int l3 = lane; asm volatile("" : "+v"(l3)); qknorm_phase(ws, args.in[7], args.in[8], gw, ngw, l3); }
#endif
        SEAM(3);
    }
    if (IN(4)) {
#ifndef SK_MLA
        for (int rep = 0; rep < (DUP == 4 ? 2 : 1); ++rep) mla::phase(ws, (char*)lds, wave);
#endif
        SEAM(4);
    }
    if (IN(5)) {
        const pg8::Gemm g{(bf16*)(ws + WS_XN), (bf16*)(ws + WS_WAO), NTOK, DM, 2048, 2048};
        const pg8::EpiRes E{args.in[0], args.out, DM, true, false};
        pg8::StaticOrder S; S.init(g.M, g.N, G, (int)blockIdx.x);
#ifndef SK_G2
        for (int rep = 0; rep < (DUP == 5 ? 2 : 1); ++rep)
        pg8::gemm_phase<pg8::EpiRes, pg8::StaticOrder, true, true, 2048, 2048>((LAS unsigned char*)lds, g, S, E, wave);
#endif
        SEAM(5);
    }
    if (IN(6)) {
        if (DUP == 66) { for (int rep = 0; rep < 20; ++rep) grid.sync(); }
        for (int rep = 0; rep < (DUP == 6 ? 2 : 1); ++rep)
        if (NTOK % (4 * ngw) == 0) { for (int m = gw; m < NTOK; m += 4 * ngw) norm_row4_nt<false>(args.out + (size_t)m * DM, (bf16*)(ws + WS_XN) + (size_t)m * DM, (size_t)ngw * DM, lane); }
        else { for (int m = gw; m < NTOK; m += ngw) norm_row(args.out + (size_t)m * DM, (bf16*)(ws + WS_XN) + (size_t)m * DM, lane); }
        SEAM(6);
    }
    for (int it = 0; it < (DUP == 7 ? 8 : 4); ++it) { const int gi = it & 3;
        if (IN(7 + 3 * gi)) {
            const pg8::Gemm g{(bf16*)(ws + WS_XN), (bf16*)(ws + WS_WBALL) + (size_t)gi * GN * 2048, NTOK, GN, 2048, 2048};
            const pg8::EpiStNorm E{(bf16*)(ws + WS_G), GCOLS, 18, (bf16*)(ws + WS_GATE), DM, gi * 512, args.in[15], args.in[12], (LAS float*)((LAS unsigned char*)lds + 131072), QSCALE_B, EPSN};
            pg8::StaticOrder S; S.init(g.M, g.N, G, (int)blockIdx.x);
#ifndef SK_G1
            pg8::gemm_phase<pg8::EpiStNorm, pg8::StaticOrder, true, true, 2048, 2048>((LAS unsigned char*)lds, g, S, E, wave);
#endif
            SEAM(7 + 3 * gi);
        }
        if (IN(8 + 3 * gi)) {
#ifndef SK_DIL
            int lane2 = lane; asm volatile("" : "+v"(lane2));
            char* wlds = (char*)lds + wave * 16384;
            const int gwx = (G % 8 == 0) ? ((int)(blockIdx.x & 7) * (G / 8) + (int)(blockIdx.x >> 3)) * 8 + wave : gw;
            for (int rep = 0; rep < (DUP == 8 ? 2 : 1); ++rep)
            for (int w = gwx; w < 12288; w += ngw)
                dil::wave_item(w, gi, (const bf16*)(ws + WS_G), args.in[15], args.in[12], (bf16*)(ws + WS_OP), (float*)(ws + WS_LSE), wlds, lane2);
#endif
            SEAM(8 + 3 * gi);
        }
        if (IN(9 + 3 * gi)) {
            int lane2 = lane; asm volatile("" : "+v"(lane2));
            const int hh = lane2 >> 4, e0 = 8 * (lane2 & 15);
            const bf16* OP = (const bf16*)(ws + WS_OP); const float* LSE = (const float*)(ws + WS_LSE);
            const bf16* GATE = (const bf16*)(ws + WS_GATE); bf16* OG = (bf16*)(ws + WS_OG);
            for (int t0 = gw; t0 < NTOK; t0 += 2 * ngw) {
                float ls[2][3]; u32x4 ov[2][3], gv[2]; size_t oc[2]; bool ok[2];
#pragma unroll
                for (int k = 0; k < 2; ++k) { const int t = t0 + k * ngw; ok[k] = t < NTOK; const int tc = ok[k] ? t : t0;
                    oc[k] = (size_t)tc * DM + (gi * 4 + hh) * 128 + e0;
#pragma unroll
                    for (int br = 0; br < 3; ++br) { ls[k][br] = __builtin_nontemporal_load(LSE + ((size_t)br * NTOK + tc) * 4 + hh); ov[k][br] = __builtin_nontemporal_load((const u32x4*)(OP + ((size_t)br * NTOK + tc) * 512 + hh * 128 + e0)); }
                    gv[k] = __builtin_nontemporal_load((const u32x4*)(GATE + oc[k])); }
#pragma unroll
                for (int k = 0; k < 2; ++k) {
                    const float mx = fmaxf(ls[k][0], fmaxf(ls[k][1], ls[k][2]));
                    float w0 = __builtin_amdgcn_exp2f(ls[k][0] - mx), w1 = __builtin_amdgcn_exp2f(ls[k][1] - mx), w2 = __builtin_amdgcn_exp2f(ls[k][2] - mx);
                    const float inv = __builtin_amdgcn_rcpf(w0 + w1 + w2); w0 *= inv; w1 *= inv; w2 *= inv;
                    u32x4 res;
#pragma unroll
                    for (int j = 0; j < 4; ++j) {
                        const float a = w0 * bflo(ov[k][0][j]) + w1 * bflo(ov[k][1][j]) + w2 * bflo(ov[k][2][j]);
                        const float c = w0 * bfhi(ov[k][0][j]) + w1 * bfhi(ov[k][1][j]) + w2 * bfhi(ov[k][2][j]);
                        res[j] = cvtpk(a * silu_f(bflo(gv[k][j])), c * silu_f(bfhi(gv[k][j]))); }
                    if (ok[k]) *(u32x4*)(OG + oc[k]) = res; }
            }
            if (gi == 3) SEAM(9 + 3 * gi);
        }
    }
    if (IN(19)) {
        const pg8::Gemm g{(bf16*)(ws + WS_OG), (bf16*)(ws + WS_WBO), NTOK, DM, 2048, 2048};
        const pg8::EpiRes E{args.out, args.out, DM, true, true};
        pg8::StaticOrder S; S.init(g.M, g.N, G, (int)blockIdx.x);
#ifndef SK_G2
        pg8::gemm_phase<pg8::EpiRes, pg8::StaticOrder, true, true, 2048, 2048>((LAS unsigned char*)lds, g, S, E, wave);
#endif
    }
#undef IN
#undef SEAM
#undef lane
}

#ifndef ONE_LAUNCH
#define ONE_LAUNCH 1
#endif
extern "C" void kernel_launch(void* const* d_in, const int* in_sizes, int n_in, void* d_out, int out_size, void* d_ws, size_t ws_size, hipStream_t stream) {
    static int grid = 0;
    if (grid == 0) {
        if (n_in != 17 || in_sizes[0] != NTOK * DM || out_size != NTOK * DM || ws_size < WS_END) {
            fprintf(stderr, "kernel_launch: unexpected shapes (n_in %d, in0 %d, out %d, ws %zu < %zu)\n", n_in, n_in > 0 ? in_sizes[0] : -1, out_size, ws_size, (size_t)WS_END); grid = -1; return; }
        int dev = 0, cus = 0, per_cu = 0;
        (void)hipGetDevice(&dev); (void)hipDeviceGetAttribute(&cus, hipDeviceAttributeMultiprocessorCount, dev);
        if (hipFuncSetAttribute((const void*)yoco_fwd, hipFuncAttributeMaxDynamicSharedMemorySize, LDS_BYTES) != hipSuccess) { fprintf(stderr, "kernel_launch: hipFuncSetAttribute failed\n"); grid = -1; return; }
        (void)hipOccupancyMaxActiveBlocksPerMultiprocessor(&per_cu, (const void*)yoco_fwd, 512, LDS_BYTES);
        (void)hipGetLastError();
        if (per_cu < 1) per_cu = 1;
        grid = cus > 0 ? cus : 256;
    }
    if (grid < 0) return;
    Args a{};
    for (int i = 0; i < 17; ++i) a.in[i] = (const float*)d_in[i];
    a.out = (float*)d_out; a.ws = (unsigned char*)d_ws;
#if ONE_LAUNCH
    a.ph_lo = 0; a.ph_hi = NPHASE;
    void* kargs[] = {&a};
    hipError_t e = hipLaunchCooperativeKernel((const void*)yoco_fwd, dim3(grid), dim3(512), kargs, LDS_BYTES, stream);
    if (e != hipSuccess) fprintf(stderr, "cooperative launch failed: %s (grid %d)\n", hipGetErrorString(e), grid);
#else
    for (int ph = 0; ph < NPHASE; ++ph) { a.ph_lo = ph; a.ph_hi = ph + 1;
        hipLaunchKernelGGL(yoco_fwd, dim3(grid), dim3(512), LDS_BYTES, stream, a); }
#endif
}
```

```cpp
#include <hip/hip_runtime.h>
#include <hip/hip_cooperative_groups.h>
#include <cstdio>
#include <cstdint>
namespace cg = cooperative_groups;
__device__ __forceinline__ int lane_id() { return (int)__builtin_amdgcn_mbcnt_hi(~0u, __builtin_amdgcn_mbcnt_lo(~0u, 0u)); }
namespace pg8 {
#define PG8_LAS __attribute__((address_space(3)))
typedef unsigned short bf16_t;
typedef short bf16x8 __attribute__((ext_vector_type(8)));
typedef float f32x4 __attribute__((ext_vector_type(4)));
typedef unsigned u32x4 __attribute__((ext_vector_type(4)));
constexpr int BM = 256, BK = 64, HALF = 128, HTB = HALF * BK * 2  , STAGE_BYTES = 8 * HTB, NXCD = 8, WGM = 4;

__host__ __device__ __forceinline__ int lds_byte(int r, int c) { const int st = (r >> 4) * 2 + (c >> 5), rr = r & 15, cc = c & 31, ob = rr * 64 + cc * 2; return st * 1024 + (ob ^ (((ob >> 9) & 1) << 5)); }
__host__ __device__ __forceinline__ void stage_rc(int b, int& R, int& C) { const int st = b / 1024, sb = b % 1024, swz = sb ^ (((sb >> 9) & 1) << 5); R = (st >> 1) * 16 + swz / 64; C = (st & 1) * 32 + (swz % 64) / 2; }
__host__ __device__ __forceinline__ int perm32(int rho) { const int n = rho >> 4, i = rho & 15; return 8 * (i >> 2) + 4 * n + (i & 3); }

struct Unit { int pm, pn; };
struct Gemm { const bf16_t* A; const bf16_t* Bt; int M, N, K, lda; };

struct StaticOrder {
    int nM, nN, nwg, G, c;
    __host__ __device__ void init(int M, int N, int G_, int c_) { nM = M / BM; nN = N / BM; nwg = nM * nN; G = G_; c = c_; }
    __host__ __device__ bool next(int i, Unit& u) const {
        const long L = (long)i * G + c; if (L >= nwg) return false;
        int wgid = (int)L; { const int q = nwg / NXCD, r = nwg % NXCD, xcd = wgid % NXCD, off = wgid / NXCD; wgid = (xcd < r ? xcd * (q + 1) : r * (q + 1) + (xcd - r) * q) + off; }
        const int nig = WGM * nN, gid = wgid / nig, fm = gid * WGM, gsz = (nM - fm) < WGM ? (nM - fm) : WGM;
        u.pm = fm + ((wgid % nig) % gsz); u.pn = (wgid % nig) / gsz; return true;
    }
    __device__ __forceinline__ void a_ready(const Unit&) const {}
    __device__ __forceinline__ void done(const Unit&) const {}
};

__device__ __forceinline__ unsigned cvt_pk_bf16(float lo, float hi) { unsigned r; asm volatile("v_cvt_pk_bf16_f32 %0, %1, %2" : "=v"(r) : "v"(lo), "v"(hi)); return r; }
template <class Epi, class Sched, bool ALIGN_EPI, bool SP2, int KC, int LDAC>
__device__ __forceinline__ void gemm_phase(PG8_LAS unsigned char* lds, const Gemm g, const Sched& S, const Epi& E, int wid_in) {
    const int wid = __builtin_amdgcn_readfirstlane(wid_in), lane = lane_id(), tid = wid * 64 + lane, wr = wid >> 2, wc = wid & 3, fr = lane & 15, fq = lane >> 4;
    constexpr int K = KC, nt = K / BK, lda = LDAC;
    unsigned voffA[2], voffB[2];
#pragma unroll
    for (int i = 0; i < 2; ++i) { int R, C; stage_rc(tid * 16 + i * 8192, R, C); const int Rb = Epi::PERM ? ((R & ~31) + perm32(R & 31)) : R;
        voffA[i] = (unsigned)(R * lda + C) * 2u; voffB[i] = (unsigned)(Rb * K + C) * 2u; }
    const size_t kstep = (size_t)(BK * 2);
    const size_t hstep = (size_t)HALF * K * 2;
    const size_t tstep = 2 * hstep; const size_t hstepA = (size_t)HALF * lda * 2, tstepA = 2 * hstepA;
    const unsigned ldsw = (unsigned)wid * 1024u;
    const int aoff = lds_byte(wr * 64 + fr, fq * 8), boff = lds_byte(wc * 32 + fr, fq * 8);
#define PG8_SA(b, h) (((b) * 2 + (h)) * HTB)
#define PG8_SB(b, h) ((4 + (b) * 2 + (h)) * HTB)
#define PG8_STAGE(bufoff, gbase, voff) do { _Pragma("unroll") for (int _i = 0; _i < 2; ++_i) \
        __builtin_amdgcn_global_load_lds((const unsigned*)((const char*)(gbase) + (voff)[_i]), (PG8_LAS unsigned*)(lds + (bufoff) + ldsw + _i * 8192), 16, 0, 0); } while (0)
#define PG8_LDA(dst, b, h) do { _Pragma("unroll") for (int m = 0; m < 4; ++m) _Pragma("unroll") for (int k = 0; k < 2; ++k) dst[m][k] = *(const PG8_LAS bf16x8*)(lds + PG8_SA(b, h) + aoff + m * 2048 + k * 1024); } while (0)
#define PG8_LDB(dst, b, h) do { _Pragma("unroll") for (int n = 0; n < 2; ++n) _Pragma("unroll") for (int k = 0; k < 2; ++k) dst[n][k] = *(const PG8_LAS bf16x8*)(lds + PG8_SB(b, h) + boff + n * 2048 + k * 1024); } while (0)
#define PG8_MMA(ai, bj, At, Bt) do { __builtin_amdgcn_s_setprio(1); _Pragma("unroll") for (int m = 0; m < 4; ++m) _Pragma("unroll") for (int n = 0; n < 2; ++n) _Pragma("unroll") for (int k = 0; k < 2; ++k) \
        acc[ai][bj][m][n] = __builtin_amdgcn_mfma_f32_16x16x32_bf16(Bt[n][k], At[m][k], acc[ai][bj][m][n], 0, 0, 0); __builtin_amdgcn_s_setprio(0); } while (0)
#define PG8_WAIT_V(n) asm volatile("s_waitcnt vmcnt(" #n ")" ::: "memory")
#define PG8_WAIT_L(n) asm volatile("s_waitcnt lgkmcnt(" #n ")" ::: "memory")
#define PG8_BAR __builtin_amdgcn_s_barrier()
#define PG8_SCHED __builtin_amdgcn_sched_barrier(0)
    Unit cur, nxt; int ui = 0;
    if (!S.next(0, cur)) return;
    f32x4 acc[2][2][4][2];
#pragma unroll
    for (int a = 0; a < 2; ++a)
#pragma unroll
        for (int b = 0; b < 2; ++b)
#pragma unroll
            for (int m = 0; m < 4; ++m)
#pragma unroll
                for (int n = 0; n < 2; ++n) acc[a][b][m][n] = (f32x4){0.f, 0.f, 0.f, 0.f};
    bf16x8 At[4][2], B0[2][2], B1[2][2];
    const char* cA = (const char*)g.A + (size_t)cur.pm * tstepA; const char* cB = (const char*)g.Bt + (size_t)cur.pn * tstep;
    S.a_ready(cur);
    if constexpr (SP2) {
        PG8_STAGE(PG8_SB(0, 0), cB, voffB); PG8_STAGE(PG8_SB(0, 1), cB + hstep, voffB); PG8_STAGE(PG8_SA(0, 0), cA, voffA); PG8_STAGE(PG8_SA(0, 1), cA + hstepA, voffA);
        if (wr == 1) PG8_BAR;
        PG8_WAIT_V(2); PG8_BAR;
        PG8_STAGE(PG8_SB(1, 0), cB + kstep, voffB); PG8_STAGE(PG8_SA(1, 0), cA + kstep, voffA); PG8_STAGE(PG8_SB(1, 1), cB + hstep + kstep, voffB);
        PG8_WAIT_V(6); PG8_BAR;
    } else {
        PG8_STAGE(PG8_SB(0, 0), cB, voffB); PG8_STAGE(PG8_SA(0, 0), cA, voffA); PG8_STAGE(PG8_SB(0, 1), cB + hstep, voffB); PG8_STAGE(PG8_SA(0, 1), cA + hstepA, voffA);
        if (wr == 1) PG8_BAR;
        PG8_WAIT_V(4); PG8_BAR;
        PG8_STAGE(PG8_SB(1, 0), cB + kstep, voffB); PG8_STAGE(PG8_SA(1, 0), cA + kstep, voffA); PG8_STAGE(PG8_SB(1, 1), cB + hstep + kstep, voffB);
        PG8_WAIT_V(6); PG8_BAR;
    }
    for (;;) {
        const bool has_next = S.next(ui + 1, nxt);
        const char* nA = has_next ? (const char*)g.A + (size_t)nxt.pm * tstepA : cA; const char* nB = has_next ? (const char*)g.Bt + (size_t)nxt.pn * tstep : cB;
        for (int t = 0; t < nt; t += 2) {
            const bool last = (t == nt - 2);
            const char* a1 = cA + (size_t)(t + 1) * kstep;
            const char* a2 = last ? nA : cA + (size_t)(t + 2) * kstep; const char* b2 = last ? nB : cB + (size_t)(t + 2) * kstep;
            const char* a3 = a2 + kstep; const char* b3 = b2 + kstep;
            if (last && has_next) S.a_ready(nxt);
            if constexpr (SP2) {
            PG8_LDB(B0, 0, 0); PG8_LDB(B1, 0, 1); PG8_SCHED; PG8_LDA(At, 0, 0); PG8_STAGE(PG8_SA(1, 1), a1 + hstepA, voffA);
            PG8_WAIT_V(8); PG8_WAIT_L(0); PG8_BAR; PG8_MMA(0, 0, At, B0); PG8_MMA(0, 1, At, B1); PG8_BAR; PG8_SCHED;
            PG8_LDA(At, 0, 1); PG8_STAGE(PG8_SB(0, 0), b2, voffB); PG8_STAGE(PG8_SB(0, 1), b2 + hstep, voffB); PG8_STAGE(PG8_SA(0, 0), a2, voffA);
            PG8_WAIT_V(8); PG8_WAIT_L(0); PG8_BAR; PG8_MMA(1, 0, At, B0); PG8_MMA(1, 1, At, B1); PG8_BAR; PG8_SCHED;
            PG8_LDB(B0, 1, 0); PG8_LDB(B1, 1, 1); PG8_SCHED; PG8_LDA(At, 1, 0); PG8_STAGE(PG8_SA(0, 1), a2 + hstepA, voffA);
            PG8_WAIT_V(8); PG8_WAIT_L(0); PG8_BAR; PG8_MMA(0, 0, At, B0); PG8_MMA(0, 1, At, B1); PG8_BAR; PG8_SCHED;
            PG8_LDA(At, 1, 1); PG8_STAGE(PG8_SB(1, 0), b3, voffB); PG8_STAGE(PG8_SB(1, 1), b3 + hstep, voffB); PG8_STAGE(PG8_SA(1, 0), a3, voffA);
            PG8_WAIT_V(8); PG8_WAIT_L(0); PG8_BAR; PG8_MMA(1, 0, At, B0); PG8_MMA(1, 1, At, B1); PG8_BAR; PG8_SCHED;
            } else {
            PG8_LDB(B0, 0, 0); PG8_SCHED; PG8_LDA(At, 0, 0); PG8_STAGE(PG8_SA(1, 1), a1 + hstepA, voffA);
            PG8_WAIT_L(8); PG8_BAR; PG8_WAIT_L(0); PG8_MMA(0, 0, At, B0); PG8_BAR; PG8_SCHED;
            PG8_LDB(B1, 0, 1); PG8_STAGE(PG8_SB(0, 0), b2, voffB);
            PG8_BAR; PG8_WAIT_L(0); PG8_MMA(0, 1, At, B1); PG8_BAR;
            PG8_LDA(At, 0, 1); PG8_STAGE(PG8_SA(0, 0), a2, voffA);
            PG8_BAR; PG8_WAIT_L(0); PG8_MMA(1, 0, At, B0); PG8_BAR; PG8_SCHED;
            PG8_STAGE(PG8_SB(0, 1), b2 + hstep, voffB);
            PG8_WAIT_V(6); PG8_BAR; PG8_MMA(1, 1, At, B1); PG8_BAR;
            PG8_LDB(B0, 1, 0); PG8_SCHED; PG8_LDA(At, 1, 0); PG8_STAGE(PG8_SA(0, 1), a2 + hstepA, voffA);
            PG8_WAIT_L(8); PG8_BAR; PG8_WAIT_L(0); PG8_MMA(0, 0, At, B0); PG8_BAR; PG8_SCHED;
            PG8_LDB(B1, 1, 1); PG8_STAGE(PG8_SB(1, 0), b3, voffB);
            PG8_BAR; PG8_WAIT_L(0); PG8_MMA(0, 1, At, B1); PG8_BAR;
            PG8_LDA(At, 1, 1); PG8_STAGE(PG8_SA(1, 0), a3, voffA);
            PG8_BAR; PG8_WAIT_L(0); PG8_MMA(1, 0, At, B0); PG8_BAR; PG8_SCHED;
            PG8_STAGE(PG8_SB(1, 1), b3 + hstep, voffB);
            PG8_WAIT_V(6); PG8_BAR; PG8_MMA(1, 1, At, B1); PG8_BAR;
            }
        }
        if constexpr (ALIGN_EPI) { if (wr == 0) PG8_BAR; }
        if constexpr (!Epi::AFTER_DRAIN) { E(acc, cur, wr, wc, fr, fq); S.done(cur); }
        if (!has_next) break;
#pragma unroll
        for (int a = 0; a < 2; ++a)
#pragma unroll
            for (int b = 0; b < 2; ++b)
#pragma unroll
                for (int m = 0; m < 4; ++m)
#pragma unroll
                    for (int n = 0; n < 2; ++n) acc[a][b][m][n] = (f32x4){0.f, 0.f, 0.f, 0.f};
        cur = nxt; cA = nA; cB = nB; ++ui;
        if constexpr (ALIGN_EPI) { if (wr == 1) PG8_BAR; }
    }
    PG8_WAIT_V(0);
    if constexpr (!ALIGN_EPI) { if (wr == 0) PG8_BAR; }
    PG8_BAR;
    if constexpr (Epi::AFTER_DRAIN) { E.fused(acc, cur, wr, wc, fr, fq, lds, wid, lane); S.done(cur); }
#undef PG8_SA
#undef PG8_SB
#undef PG8_STAGE
#undef PG8_LDA
#undef PG8_LDB
#undef PG8_MMA
#undef PG8_WAIT_V
#undef PG8_WAIT_L
#undef PG8_BAR
#undef PG8_SCHED
}
}

namespace pg8 {
struct EpiSt {
    static constexpr bool PERM = true, AFTER_DRAIN = false;
    bf16_t* O; int ldc; int ncut; bf16_t* O2; int ldc2; int col2;
    __device__ __forceinline__ void operator()(const f32x4 (&acc)[2][2][4][2], const Unit& u, int wr, int wc, int fr, int fq) const {
        const int row0 = u.pm * BM + wr * 64 + fr;
        bf16_t* base = O; int ld = ldc; int colt = u.pn * BM;
        if (u.pn >= ncut) { base = O2; ld = ldc2; colt = col2 + (u.pn - ncut) * BM; }
        const int col0 = colt + wc * 32 + 8 * fq;
#pragma unroll
        for (int ai = 0; ai < 2; ++ai)
#pragma unroll
            for (int m = 0; m < 4; ++m) { bf16_t* rowp = base + (size_t)(row0 + ai * HALF + m * 16) * ld + col0;
#pragma unroll
                for (int bj = 0; bj < 2; ++bj) { const f32x4 v0 = acc[ai][bj][m][0], v1 = acc[ai][bj][m][1];
                    u32x4 w; w.x = cvt_pk_bf16(v0[0], v0[1]); w.y = cvt_pk_bf16(v0[2], v0[3]); w.z = cvt_pk_bf16(v1[0], v1[1]); w.w = cvt_pk_bf16(v1[2], v1[3]);
                    *(u32x4*)(rowp + bj * HALF) = w; } }
    }
};
struct EpiStNorm {
    static constexpr bool PERM = true, AFTER_DRAIN = false;
    bf16_t* O; int ldc; int ncut; bf16_t* O2; int ldc2; int col2; const float* gq; const float* gk; PG8_LAS float* P; float qscale, eps;
    __device__ __forceinline__ void operator()(const f32x4 (&acc)[2][2][4][2], const Unit& u, int wr, int wc, int fr, int fq) const {
        const int row0 = u.pm * BM + wr * 64 + fr;
        const bool gate = u.pn >= ncut;
        bf16_t* base = O; int ld = ldc; int colt = u.pn * BM;
        if (gate) { base = O2; ld = ldc2; colt = col2 + (u.pn - ncut) * BM; }
        const int col0 = colt + wc * 32 + 8 * fq;
        int part[2], br[2];
#pragma unroll
        for (int bj = 0; bj < 2; ++bj) { const int rem = (u.pn * 2 + bj) % 9; part[bj] = gate ? 2 : rem / 3; br[bj] = rem % 3; }
        f32x4 cg[2][2];
#pragma unroll
        for (int bj = 0; bj < 2; ++bj) {
            cg[bj][0] = (f32x4){1.f, 1.f, 1.f, 1.f}; cg[bj][1] = cg[bj][0];
            if (part[bj] == 0) { const int e = br[bj] * 128 + wc * 32 + 8 * fq;
                cg[bj][0] = *(const f32x4*)(gq + e) * *(const f32x4*)(gk + e) * qscale; cg[bj][1] = *(const f32x4*)(gq + e + 4) * *(const f32x4*)(gk + e + 4) * qscale; } }
        float sc[2][2][4];
#pragma unroll
        for (int ai = 0; ai < 2; ++ai)
#pragma unroll
            for (int bj = 0; bj < 2; ++bj)
#pragma unroll
                for (int m = 0; m < 4; ++m) sc[ai][bj][m] = 1.f;
        if (part[0] < 2 || part[1] < 2) {
#pragma unroll
            for (int ai = 0; ai < 2; ++ai)
#pragma unroll
                for (int bj = 0; bj < 2; ++bj)
#pragma unroll
                    for (int m = 0; m < 4; ++m) if (part[bj] < 2) { const f32x4 a = acc[ai][bj][m][0], b = acc[ai][bj][m][1];
                        float q = (a[0] * a[0] + a[1] * a[1]) + (a[2] * a[2] + a[3] * a[3]) + (b[0] * b[0] + b[1] * b[1]) + (b[2] * b[2] + b[3] * b[3]);
                        { auto rr = __builtin_amdgcn_permlane16_swap(__float_as_uint(q), __float_as_uint(q), false, false); q = __uint_as_float(rr[0]) + __uint_as_float(rr[1]); }
                        { auto rr = __builtin_amdgcn_permlane32_swap(__float_as_uint(q), __float_as_uint(q), false, false); q = __uint_as_float(rr[0]) + __uint_as_float(rr[1]); }
                        if (fq == 0) P[(bj * 256 + ai * HALF + wr * 64 + m * 16 + fr) * 4 + wc] = q; }
            asm volatile("s_waitcnt lgkmcnt(0)\n\ts_barrier" ::: "memory");
#pragma unroll
            for (int ai = 0; ai < 2; ++ai)
#pragma unroll
                for (int bj = 0; bj < 2; ++bj)
#pragma unroll
                    for (int m = 0; m < 4; ++m) if (part[bj] < 2) { const f32x4 t = *(const PG8_LAS f32x4*)(P + (bj * 256 + ai * HALF + wr * 64 + m * 16 + fr) * 4);
                        sc[ai][bj][m] = __builtin_amdgcn_rsqf(((t[0] + t[1]) + (t[2] + t[3])) * (1.0f / 128.0f) + eps); }
        }
#pragma unroll
        for (int ai = 0; ai < 2; ++ai)
#pragma unroll
            for (int m = 0; m < 4; ++m) { bf16_t* rowp = base + (size_t)(row0 + ai * HALF + m * 16) * ld + col0;
#pragma unroll
                for (int bj = 0; bj < 2; ++bj) { const f32x4 v0 = acc[ai][bj][m][0] * cg[bj][0] * sc[ai][bj][m], v1 = acc[ai][bj][m][1] * cg[bj][1] * sc[ai][bj][m];
                    u32x4 w; w.x = cvt_pk_bf16(v0[0], v0[1]); w.y = cvt_pk_bf16(v0[2], v0[3]); w.z = cvt_pk_bf16(v1[0], v1[1]); w.w = cvt_pk_bf16(v1[2], v1[3]);
                    *(u32x4*)(rowp + bj * HALF) = w; } }
    }
};
struct EpiRes {
    static constexpr bool PERM = false, AFTER_DRAIN = false;
    const float* base; float* out; int ldc; bool nt_ld, nt_st;
    __device__ __forceinline__ void operator()(const f32x4 (&acc)[2][2][4][2], const Unit& u, int wr, int wc, int fr, int fq) const {
        const int col0 = u.pn * BM + wc * 32 + 4 * fq;
#pragma unroll
        for (int ai = 0; ai < 2; ++ai) {
            const size_t off0 = (size_t)(u.pm * BM + ai * HALF + wr * 64 + fr) * ldc + col0;
            f32x4 bs[4][2][2];
#pragma unroll
            for (int m = 0; m < 4; ++m)
#pragma unroll
                for (int bj = 0; bj < 2; ++bj)
#pragma unroll
                    for (int n = 0; n < 2; ++n) { const f32x4* p_ = (const f32x4*)(base + off0 + (size_t)m * 16 * ldc + bj * HALF + n * 16); bs[m][bj][n] = nt_ld ? __builtin_nontemporal_load(p_) : *p_; }
            asm volatile("" ::: "memory");
#pragma unroll
            for (int m = 0; m < 4; ++m)
#pragma unroll
                for (int bj = 0; bj < 2; ++bj)
#pragma unroll
                    for (int n = 0; n < 2; ++n) { f32x4* q_ = (f32x4*)(out + off0 + (size_t)m * 16 * ldc + bj * HALF + n * 16); const f32x4 r_ = bs[m][bj][n] + acc[ai][bj][m][n]; if (nt_st) __builtin_nontemporal_store(r_, q_); else *q_ = r_; }
            asm volatile("" ::: "memory");
        }
    }
};
}

constexpr int SEQ = 16384, NTOK = 32768, DM = 2048;
constexpr int UCOLS = 3328;
constexpr int QCOLS = 3072, KVCOLS = 4096, KRCOLS = 1024;
constexpr int GCOLS = 4608, GN = 5120;
constexpr float EPSN = 1e-6f;
constexpr float LOG2E = 1.4426950408889634f;
constexpr float QSCALE_A = 0.10411754627697264f;
constexpr float QSCALE_B = 0.12751743082459868f;
constexpr size_t MiB = 1u << 20;
constexpr size_t WS_WAIN = 0, WS_WQUP = 14 * MiB, WS_WKVUP = 17 * MiB, WS_WAO = 21 * MiB, WS_WBALL = 29 * MiB, WS_WBO = 109 * MiB;
constexpr size_t WS_LSE = 120 * MiB, WS_ROPE = 122 * MiB;
constexpr size_t WS_XN = 144 * MiB;
constexpr size_t WS_U = 272 * MiB, WS_Q = 480 * MiB, WS_KV = 672 * MiB, WS_KR = 928 * MiB;
constexpr size_t WS_G = 272 * MiB, WS_GATE = 560 * MiB, WS_OP = 688 * MiB, WS_OG = 784 * MiB;
constexpr size_t WS_END = 992 * MiB;
constexpr int LDS_BYTES = 147456;
constexpr int NPHASE = 20;
constexpr int DUP = 0;

typedef unsigned short bf16;
typedef short bf16x8 __attribute__((ext_vector_type(8)));
typedef short s16x4 __attribute__((ext_vector_type(4)));
typedef float f32x16 __attribute__((ext_vector_type(16)));
typedef float f32x4 __attribute__((ext_vector_type(4)));
typedef unsigned u32x4 __attribute__((ext_vector_type(4)));
typedef unsigned u32x2 __attribute__((ext_vector_type(2)));
#define LAS __attribute__((address_space(3)))

struct Args { const float* in[17]; float* out; unsigned char* ws; int ph_lo, ph_hi; };

__device__ __forceinline__ float bf2f(unsigned short h) { return __uint_as_float((unsigned)h << 16); }
__device__ __forceinline__ float bflo(unsigned w) { return __uint_as_float(w << 16); }
__device__ __forceinline__ float bfhi(unsigned w) { return __uint_as_float(w & 0xffff0000u); }
__device__ __forceinline__ unsigned cvtpk(float lo, float hi) { unsigned r; asm volatile("v_cvt_pk_bf16_f32 %0, %1, %2" : "=v"(r) : "v"(lo), "v"(hi)); return r; }
__device__ __forceinline__ unsigned short f2bf(float f) { return (unsigned short)(cvtpk(f, 0.f) & 0xffffu); }
__device__ __forceinline__ float wave_sum(float v) {
#pragma unroll
    for (int o = 1; o < 64; o <<= 1) v += __shfl_xor(v, o);
    return v;
}
__device__ __forceinline__ float silu_f(float g) { return g * __builtin_amdgcn_rcpf(1.f + __builtin_amdgcn_exp2f(g * -1.4426950408889634f)); }

__device__ __forceinline__ int dst_row(int map, int n0) {
    if (map == 0) return n0;
    if (map == 1) { const int part2 = n0 / 6144, r = n0 % 6144, br = r / 2048, h = (r % 2048) / 128, e = r % 128;
        return (h >> 2) * GN + (h & 3) * 1152 + (1 + part2) * 384 + br * 128 + e; }
    if (n0 < 6144) { const int br = n0 / 2048, h = (n0 % 2048) / 128, e = n0 % 128; return (h >> 2) * GN + (h & 3) * 1152 + br * 128 + e; }
    { const int c = n0 - 6144, h = c / 128, e = c % 128; return (h >> 2) * GN + GCOLS + (h & 3) * 128 + e; }
}
__device__ __forceinline__ void transpose_item(const float* W, int K, int N, const float* gain, bf16* WT, int map, LAS float* scr, int item, int lane) {
    const int nblk = N / 32, kb = item / nblk, nb = item % nblk, k0 = 64 * kb, n0 = 32 * nb;
    float wv[32];
#pragma unroll
    for (int i = 0; i < 32; ++i) wv[i] = __builtin_nontemporal_load(W + (size_t)(k0 + 2 * i + (lane >> 5)) * N + n0 + (lane & 31));
#pragma unroll
    for (int i = 0; i < 32; ++i) { const int kk = 2 * i + (lane >> 5); const float gsc = gain ? gain[k0 + kk] : 1.f;
        scr[kk * 33 + (lane & 31)] = wv[i] * gsc; }
    asm volatile("s_waitcnt lgkmcnt(0)" ::: "memory");
    const int c = lane & 7; const int d0 = dst_row(map, n0);
#pragma unroll
    for (int j = 0; j < 4; ++j) { const int n = (lane >> 3) + 8 * j; const LAS float* s = scr + (8 * c) * 33 + n;
        u32x4 o; o.x = cvtpk(s[0 * 33], s[1 * 33]); o.y = cvtpk(s[2 * 33], s[3 * 33]); o.z = cvtpk(s[4 * 33], s[5 * 33]); o.w = cvtpk(s[6 * 33], s[7 * 33]);
        *(u32x4*)(WT + (size_t)(d0 + n) * K + k0 + 8 * c) = o; }
    asm volatile("s_waitcnt lgkmcnt(0)" ::: "memory");
}
__device__ __forceinline__ void norm_row(const float* xrow, bf16* orow, int lane) {
    const f32x4* xr = (const f32x4*)xrow + lane;
    f32x4 v[8]; float s = 0.f;
#pragma unroll
    for (int j = 0; j < 8; ++j) { v[j] = xr[64 * j]; s += (v[j].x * v[j].x + v[j].y * v[j].y) + (v[j].z * v[j].z + v[j].w * v[j].w); }
    const float rstd = __builtin_amdgcn_rsqf(wave_sum(s) * (1.f / DM) + EPSN);
    u32x2* o8 = (u32x2*)orow + lane;
#pragma unroll
    for (int j = 0; j < 8; ++j) { u32x2 w; w.x = cvtpk(v[j].x * rstd, v[j].y * rstd); w.y = cvtpk(v[j].z * rstd, v[j].w * rstd); o8[64 * j] = w; }
}

template <bool NT_> __device__ __forceinline__ void norm_row2(const float* xa, bf16* oa, const float* xb, bf16* ob, int lane) {
    const f32x4* ra = (const f32x4*)xa + lane; const f32x4* rb = (const f32x4*)xb + lane;
    f32x4 va[8], vb[8]; float sa = 0.f, sb = 0.f;
#pragma unroll
    for (int j = 0; j < 8; ++j) { if (NT_) { va[j] = __builtin_nontemporal_load(ra + 64 * j); vb[j] = __builtin_nontemporal_load(rb + 64 * j); } else { va[j] = ra[64 * j]; vb[j] = rb[64 * j]; } }
#pragma unroll
    for (int j = 0; j < 8; ++j) { sa += (va[j].x * va[j].x + va[j].y * va[j].y) + (va[j].z * va[j].z + va[j].w * va[j].w);
                                  sb += (vb[j].x * vb[j].x + vb[j].y * vb[j].y) + (vb[j].z * vb[j].z + vb[j].w * vb[j].w); }
    const float rsa = __builtin_amdgcn_rsqf(wave_sum(sa) * (1.f / DM) + EPSN), rsb = __builtin_amdgcn_rsqf(wave_sum(sb) * (1.f / DM) + EPSN);
    u32x2* pa = (u32x2*)oa + lane; u32x2* pb = (u32x2*)ob + lane;
#pragma unroll
    for (int j = 0; j < 8; ++j) { u32x2 w; w.x = cvtpk(va[j].x * rsa, va[j].y * rsa); w.y = cvtpk(va[j].z * rsa, va[j].w * rsa); pa[64 * j] = w;
                                  u32x2 z; z.x = cvtpk(vb[j].x * rsb, vb[j].y * rsb); z.y = cvtpk(vb[j].z * rsb, vb[j].w * rsb); pb[64 * j] = z; }
}

template <bool NT_> __device__ __forceinline__ void norm_row4_nt(const float* x0, bf16* o0, size_t rstride, int lane) {
    f32x4 v[4][8]; float s[4] = {0.f, 0.f, 0.f, 0.f};
#pragma unroll
    for (int k = 0; k < 4; ++k) { const f32x4* r = (const f32x4*)(x0 + k * rstride) + lane;
#pragma unroll
        for (int j = 0; j < 8; ++j) v[k][j] = NT_ ? __builtin_nontemporal_load(r + 64 * j) : r[64 * j]; }
#pragma unroll
    for (int k = 0; k < 4; ++k)
#pragma unroll
        for (int j = 0; j < 8; ++j) s[k] += (v[k][j].x * v[k][j].x + v[k][j].y * v[k][j].y) + (v[k][j].z * v[k][j].z + v[k][j].w * v[k][j].w);
#pragma unroll
    for (int k = 0; k < 4; ++k) { const float rs = __builtin_amdgcn_rsqf(wave_sum(s[k]) * (1.f / DM) + EPSN); u32x2* p = (u32x2*)(o0 + k * rstride) + lane;
#pragma unroll
        for (int j = 0; j < 8; ++j) { u32x2 w; w.x = cvtpk(v[k][j].x * rs, v[k][j].y * rs); w.y = cvtpk(v[k][j].z * rs, v[k][j].w * rs); p[64 * j] = w; } }
}

__device__ __forceinline__ void sincos_pos(int s, int i, float& c, float& sn) {
    double inv = 1.0;
    if (i & 1) inv *= 0.7498942093324559; if (i & 2) inv *= 0.5623413251903491; if (i & 4) inv *= 0.31622776601683794; if (i & 8) inv *= 0.1; if (i & 16) inv *= 0.01;
    const double a = (double)s * inv;
    const double k = __builtin_rint(a * 0.15915494309189535);
    double r = __builtin_fma(-k, 6.283185307179586, a); r = __builtin_fma(-k, 2.4492935982947064e-16, r);
    const double r2 = r * r;
    double ps = -3.868170170630684e-23; ps = ps * r2 + 1.9572941063391263e-20; ps = ps * r2 - 8.22063524662433e-18; ps = ps * r2 + 2.8114572543455206e-15; ps = ps * r2 - 7.647163731819816e-13;
    ps = ps * r2 + 1.6059043836821613e-10; ps = ps * r2 - 2.505210838544172e-08; ps = ps * r2 + 2.7557319223985893e-06; ps = ps * r2 - 0.0001984126984126984; ps = ps * r2 + 0.008333333333333333;
    ps = ps * r2 - 0.16666666666666666; ps = ps * r2 + 1.0;
    double pc = -8.896791392450574e-22; pc = pc * r2 + 4.110317623312165e-19; pc = pc * r2 - 1.5619206968586225e-16; pc = pc * r2 + 4.779477332387385e-14; pc = pc * r2 - 1.1470745597729725e-11;
    pc = pc * r2 + 2.08767569878681e-09; pc = pc * r2 - 2.755731922398589e-07; pc = pc * r2 + 2.48015873015873e-05; pc = pc * r2 - 0.001388888888888889; pc = pc * r2 + 0.041666666666666664;
    pc = pc * r2 - 0.5; pc = pc * r2 + 1.0;
    sn = (float)(ps * r); c = (float)pc;
}
__device__ __forceinline__ void unpack8(const u32x4 a, float* f) {
#pragma unroll
    for (int j = 0; j < 4; ++j) { f[2 * j] = bflo(a[j]); f[2 * j + 1] = bfhi(a[j]); }
}
__device__ __forceinline__ u32x4 pack8f(const float* f) { u32x4 w; w.x = cvtpk(f[0], f[1]); w.y = cvtpk(f[2], f[3]); w.z = cvtpk(f[4], f[5]); w.w = cvtpk(f[6], f[7]); return w; }
__device__ __forceinline__ void qknorm_phase(unsigned char* ws, const float* gq, const float* gk, int gw, int ngw, int lane) {
    bf16* U = (bf16*)(ws + WS_U); bf16* Q = (bf16*)(ws + WS_Q); bf16* KV = (bf16*)(ws + WS_KV);
    const float* COS = (const float*)(ws + WS_ROPE); const float* SIN = COS + SEQ * 32;
    const int h = lane >> 2, part = lane & 3;
    for (int t = gw; t < NTOK; t += ngw) {
        const int s = t & (SEQ - 1);
        const float* gqp = gq; const float* gkp = gk; asm volatile("" : "+s"(gqp), "+s"(gkp));
        char* ub = (char*)(U + (size_t)t * UCOLS); char* qb = (char*)(Q + (size_t)t * QCOLS); char* kb = (char*)(KV + (size_t)t * KVCOLS);
        const unsigned oq = (unsigned)(h * 192 + part * 32) * 2u, oq1 = (unsigned)(h * 192 + 128 + part * 8) * 2u, ok = (unsigned)(h * 256 + part * 64) * 2u;
        const unsigned opeo = (unsigned)(1024 + part * 8) * 2u, okr = (unsigned)(h * 64 + part * 8) * 2u;
        bf16* urow = (bf16*)ub; bf16* qp = (bf16*)qb + h * 192; bf16* kp = (bf16*)(kb + ok);
        const u32x4 cqv = *(const u32x4*)(ub + 16u * (unsigned)lane);
        u32x4 qn[4];
#pragma unroll
        for (int i = 0; i < 4; ++i) qn[i] = *(const u32x4*)(qb + oq + 16u * i);
        const u32x4 qr1 = *(const u32x4*)(qb + oq1), qr2 = *(const u32x4*)(qb + oq1 + 64u);
        float cs[8], sn[8];
        { const char* cb_ = (const char*)(COS + s * 32); const char* sb_ = (const char*)(SIN + s * 32); unsigned ot = (unsigned)part * 32u; asm volatile("" : "+v"(ot));
          const f32x4 a = *(const f32x4*)(cb_ + ot), b = *(const f32x4*)(cb_ + ot + 16u), c = *(const f32x4*)(sb_ + ot), d = *(const f32x4*)(sb_ + ot + 16u);
#pragma unroll
          for (int j = 0; j < 4; ++j) { cs[j] = a[j]; cs[4 + j] = b[j]; sn[j] = c[j]; sn[4 + j] = d[j]; } }
        float rstd_q;
        { float f[8]; unpack8(cqv, f); float q = 0.f;
#pragma unroll
          for (int j = 0; j < 8; ++j) q += f[j] * f[j];
          rstd_q = __builtin_amdgcn_rsqf(wave_sum(q) * (1.f / 512.f) + EPSN); }
        { float y[32], r1[8], r2[8]; float ssq = 0.f;
#pragma unroll
          for (int i = 0; i < 4; ++i) unpack8(qn[i], y + 8 * i);
          unpack8(qr1, r1); unpack8(qr2, r2);
#pragma unroll
          for (int j = 0; j < 32; ++j) ssq += y[j] * y[j];
#pragma unroll
          for (int j = 0; j < 8; ++j) ssq += r1[j] * r1[j] + r2[j] * r2[j];
          ssq += __shfl_xor(ssq, 1); ssq += __shfl_xor(ssq, 2);
          const float scq = rstd_q * (__builtin_amdgcn_rsqf(ssq * rstd_q * rstd_q * (1.f / 192.f) + EPSN)) * QSCALE_A;
#pragma unroll
          for (int i = 0; i < 8; ++i) { const f32x4 g = *(const f32x4*)(gqp + part * 32 + 4 * i);
#pragma unroll
              for (int j = 0; j < 4; ++j) y[4 * i + j] *= scq * g[j]; }
#pragma unroll
          for (int i = 0; i < 4; ++i) *(u32x4*)(qb + oq + 16u * i) = pack8f(y + 8 * i);
          float o1[8], o2[8];
#pragma unroll
          for (int i = 0; i < 2; ++i) { const f32x4 g1 = *(const f32x4*)(gqp + 128 + part * 8 + 4 * i), g2 = *(const f32x4*)(gqp + 160 + part * 8 + 4 * i);
#pragma unroll
              for (int j = 0; j < 4; ++j) { const int e = 4 * i + j; const float y1 = r1[e] * scq * g1[j], y2 = r2[e] * scq * g2[j];
                  o1[e] = y1 * cs[e] - y2 * sn[e]; o2[e] = y2 * cs[e] + y1 * sn[e]; } }
          *(u32x4*)(qb + oq1) = pack8f(o1); *(u32x4*)(qb + oq1 + 64u) = pack8f(o2); }
        __builtin_amdgcn_sched_barrier(0);
        const u32x4 ckvv = *(const u32x4*)(ub + 1024u + 16u * (unsigned)lane);
        const u32x4 pe1 = *(const u32x4*)(ub + opeo), pe2 = *(const u32x4*)(ub + opeo + 64u);
        u32x4 kvv[8];
#pragma unroll
        for (int i = 0; i < 8; ++i) kvv[i] = *(const u32x4*)(kb + ok + 16u * i);
        float rstd_kv, ssq_pe;
        { float f[8]; unpack8(ckvv, f); float q = 0.f;
#pragma unroll
          for (int j = 0; j < 8; ++j) q += f[j] * f[j];
          rstd_kv = __builtin_amdgcn_rsqf(wave_sum(q) * (1.f / 512.f) + EPSN); }
        float x1[8], x2[8]; unpack8(pe1, x1); unpack8(pe2, x2);
        { float q = 0.f;
#pragma unroll
          for (int j = 0; j < 8; ++j) q += x1[j] * x1[j] + x2[j] * x2[j];
          q += __shfl_xor(q, 1); q += __shfl_xor(q, 2); ssq_pe = q; }
        { float ssq = 0.f;
#pragma unroll
          for (int i = 0; i < 8; ++i) { float f[8]; unpack8(kvv[i], f);
#pragma unroll
              for (int j = 0; j < 8; ++j) ssq += f[j] * f[j]; }
          ssq = part < 2 ? ssq : 0.f;
          ssq += __shfl_xor(ssq, 1); ssq += __shfl_xor(ssq, 2);
          const float rk = __builtin_amdgcn_rsqf((ssq * rstd_kv * rstd_kv + ssq_pe) * (1.f / 192.f) + EPSN);
          const float sck = part < 2 ? rstd_kv * rk : rstd_kv;
#pragma unroll
          for (int i = 0; i < 8; ++i) { float f[8]; unpack8(kvv[i], f);
              f32x4 g0 = *(const f32x4*)(gkp + (part & 1) * 64 + 8 * i), g1 = *(const f32x4*)(gkp + (part & 1) * 64 + 8 * i + 4);
              if (part >= 2) { g0 = (f32x4){1.f, 1.f, 1.f, 1.f}; g1 = g0; }
#pragma unroll
              for (int j = 0; j < 4; ++j) { f[j] *= sck * g0[j]; f[4 + j] *= sck * g1[j]; }
              *(u32x4*)(kb + ok + 16u * i) = pack8f(f); }
          float o1[8], o2[8];
#pragma unroll
          for (int i = 0; i < 2; ++i) { const f32x4 g1 = *(const f32x4*)(gkp + 128 + part * 8 + 4 * i), g2 = *(const f32x4*)(gkp + 160 + part * 8 + 4 * i);
#pragma unroll
              for (int j = 0; j < 4; ++j) { const int e = 4 * i + j; const float y1 = x1[e] * rk * g1[j], y2 = x2[e] * rk * g2[j];
                  o1[e] = y1 * cs[e] - y2 * sn[e]; o2[e] = y2 * cs[e] + y1 * sn[e]; } }
          *(u32x4*)(ub + okr) = pack8f(o1); *(u32x4*)(ub + okr + 64u) = pack8f(o2); }
    }
}

#define SBAR() __builtin_amdgcn_sched_barrier(0)
__device__ __forceinline__ int v_st(int k, int c) { const int kk = (k & ~0xC) | ((k & 4) << 1) | ((k & 8) >> 1); return ((kk >> 3) * 4 + (c >> 5)) * 512 + ((kk & 7) * 32 + (c & 31)) * 2; }
__device__ __forceinline__ int v_rd_base(int lane) { return ((lane & 3) << 3) | (((lane >> 2) & 3) << 6) | (((lane >> 4) & 1) << 5) | (((lane >> 5) & 1) << 8); }
__device__ __forceinline__ int crow(int r, int hi) { return (r & 3) + 8 * (r >> 2) + 4 * hi; }
#define PK4(P, B_, OUT) do { unsigned a0 = cvtpk(P[B_+0], P[B_+1]), a1 = cvtpk(P[B_+2], P[B_+3]);                          \
        unsigned b0 = cvtpk(P[B_+4], P[B_+5]), b1 = cvtpk(P[B_+6], P[B_+7]);                                             \
        auto r0 = __builtin_amdgcn_permlane32_swap(a0, b0, false, false); auto r1 = __builtin_amdgcn_permlane32_swap(a1, b1, false, false); \
        u32x4 w = {r0[0], r1[0], r0[1], r1[1]}; OUT = *reinterpret_cast<bf16x8*>(&w); } while (0)
#define TRRD(dst, off) asm volatile("ds_read_b64_tr_b16 %0, %1 offset:%2" : "=&v"(dst) : "v"(vb0), "i"(off) : "memory")

namespace mla {
constexpr int SHM_V = 16384, SHM_K = 24576, OFF_K = 3 * SHM_V, OFF_WS = OFF_K + 3 * SHM_K;
__device__ __forceinline__ int kswz(int row, int colB) { return row * 384 + (colB ^ (((row >> 1) & 7) << 4)); }
#define MBAR() asm volatile("s_waitcnt lgkmcnt(0)\n\ts_barrier" ::: "memory")
__device__ __forceinline__ void qkt(f32x16& p0, f32x16& p1, const char* kbuf, const int* koff, const bf16x8* qr) {
    p0 = f32x16{}; p1 = f32x16{};
    int ka[4];
#pragma unroll
    for (int dd = 0; dd < 4; ++dd) ka[dd] = (int)(uintptr_t)kbuf + koff[dd];
    bf16x8 X0, X1, Y0, Y1, Z0, Z1;
#define KRD(S, s_) asm volatile("ds_read_b128 %0, %2 offset:%3\n\tds_read_b128 %1, %2 offset:%4" : "=&v"(S##0), "=&v"(S##1) : "v"(ka[(s_) & 3]), "i"(((s_) >> 2) * 128), "i"(((s_) >> 2) * 128 + 12288) : "memory")
#define KMM(S, s_) do { p0 = __builtin_amdgcn_mfma_f32_32x32x16_bf16(S##0, qr[s_], p0, 0, 0, 0); p1 = __builtin_amdgcn_mfma_f32_32x32x16_bf16(S##1, qr[s_], p1, 0, 0, 0); } while (0)
    KRD(X, 0); KRD(Y, 1);
    KRD(Z, 2); asm volatile("s_waitcnt lgkmcnt(4)" ::: "memory"); SBAR(); KMM(X, 0); SBAR();
    KRD(X, 3); asm volatile("s_waitcnt lgkmcnt(4)" ::: "memory"); SBAR(); KMM(Y, 1); SBAR();
    KRD(Y, 4); asm volatile("s_waitcnt lgkmcnt(4)" ::: "memory"); SBAR(); KMM(Z, 2); SBAR();
    KRD(Z, 5); asm volatile("s_waitcnt lgkmcnt(4)" ::: "memory"); SBAR(); KMM(X, 3); SBAR();
    KRD(X, 6); asm volatile("s_waitcnt lgkmcnt(4)" ::: "memory"); SBAR(); KMM(Y, 4); SBAR();
    KRD(Y, 7); asm volatile("s_waitcnt lgkmcnt(4)" ::: "memory"); SBAR(); KMM(Z, 5); SBAR();
    KRD(Z, 8); asm volatile("s_waitcnt lgkmcnt(4)" ::: "memory"); SBAR(); KMM(X, 6); SBAR();
    KRD(X, 9); asm volatile("s_waitcnt lgkmcnt(4)" ::: "memory"); SBAR(); KMM(Y, 7); SBAR();
    KRD(Y, 10); asm volatile("s_waitcnt lgkmcnt(4)" ::: "memory"); SBAR(); KMM(Z, 8); SBAR();
    KRD(Z, 11); asm volatile("s_waitcnt lgkmcnt(4)" ::: "memory"); SBAR(); KMM(X, 9); SBAR();
    asm volatile("s_waitcnt lgkmcnt(2)" ::: "memory"); SBAR(); KMM(Y, 10); SBAR();
    asm volatile("s_waitcnt lgkmcnt(0)" ::: "memory"); SBAR(); KMM(Z, 11); SBAR();
#undef KRD
#undef KMM
}
__device__ __forceinline__ void pv_tile(f32x16* o, int vb0, bf16x8 pa0, bf16x8 pa1, bf16x8 pa2, bf16x8 pa3) {
    s16x4 A0, A1, A2, A3, A4, A5, A6, A7, B0, B1, B2, B3, B4, B5, B6, B7;
#define RD8(S, d0) do { constexpr int b_ = (d0) * 512; TRRD(S##0, b_); TRRD(S##1, b_ + 2048); TRRD(S##2, b_ + 4096); TRRD(S##3, b_ + 6144); \
        TRRD(S##4, b_ + 8192); TRRD(S##5, b_ + 10240); TRRD(S##6, b_ + 12288); TRRD(S##7, b_ + 14336); } while (0)
#define MM4(S, d0) do { \
        o[d0] = __builtin_amdgcn_mfma_f32_32x32x16_bf16(pa0, (bf16x8){S##0[0], S##0[1], S##0[2], S##0[3], S##1[0], S##1[1], S##1[2], S##1[3]}, o[d0], 0, 0, 0); \
        o[d0] = __builtin_amdgcn_mfma_f32_32x32x16_bf16(pa1, (bf16x8){S##2[0], S##2[1], S##2[2], S##2[3], S##3[0], S##3[1], S##3[2], S##3[3]}, o[d0], 0, 0, 0); \
        o[d0] = __builtin_amdgcn_mfma_f32_32x32x16_bf16(pa2, (bf16x8){S##4[0], S##4[1], S##4[2], S##4[3], S##5[0], S##5[1], S##5[2], S##5[3]}, o[d0], 0, 0, 0); \
        o[d0] = __builtin_amdgcn_mfma_f32_32x32x16_bf16(pa3, (bf16x8){S##6[0], S##6[1], S##6[2], S##6[3], S##7[0], S##7[1], S##7[2], S##7[3]}, o[d0], 0, 0, 0); } while (0)
    RD8(A, 0);
    RD8(B, 1); asm volatile("s_waitcnt lgkmcnt(8)" ::: "memory"); SBAR(); MM4(A, 0); SBAR();
    RD8(A, 2); asm volatile("s_waitcnt lgkmcnt(8)" ::: "memory"); SBAR(); MM4(B, 1); SBAR();
    RD8(B, 3); asm volatile("s_waitcnt lgkmcnt(8)" ::: "memory"); SBAR(); MM4(A, 2); SBAR();
    asm volatile("s_waitcnt lgkmcnt(0)" ::: "memory"); SBAR(); MM4(B, 3);
#undef RD8
#undef MM4
}
__device__ __forceinline__ void block(int b, int h, int qb, unsigned char* ws, char* lds, int grp, int wid) {
    const bf16* Q = (const bf16*)(ws + WS_Q); const bf16* KV = (const bf16*)(ws + WS_KV); const bf16* KR = (const bf16*)(ws + WS_KR); const bf16* U = (const bf16*)(ws + WS_U); bf16* OG = (bf16*)(ws + WS_XN);
    const int lane = lane_id(), tid = wid * 64 + lane, r32 = lane & 31, hi = lane >> 5;
    const size_t tb = (size_t)b * SEQ;
    const int qlo = qb * 256 + wid * 32;
    char* V_lds = lds; char* K_lds = lds + OFF_K;
    float* wsf = (float*)(lds + OFF_WS) + wid * 64; float* li_l = wsf; float* al_l = wsf + 32;
    bf16x8 qr[12];
    { const bf16* qp = Q + (tb + qlo + r32) * QCOLS + h * 192 + hi * 8;
#pragma unroll
      for (int d0 = 0; d0 < 12; ++d0) qr[d0] = *(const bf16x8*)(qp + d0 * 16); }
    const int NT = (qb + 1) * 4;
    unsigned ko[3], ki[3], vo[2];
#pragma unroll
    for (int j = 0; j < 3; ++j) { const int pos = 1024 * (3 * wid + j) + 16 * lane, row = pos / 384, slot = (pos - row * 384) >> 4;
        const int ch = (slot & ~7) | ((slot & 7) ^ ((row >> 1) & 7));
        if (ch < 16) { ko[j] = (unsigned)WS_KV + (unsigned)((tb + row) * KVCOLS + h * 256 + ch * 8) * 2u; ki[j] = 64u * KVCOLS * 2u; }
        else { ko[j] = (unsigned)WS_U + (unsigned)((tb + row) * UCOLS + h * 64 + (ch - 16) * 8) * 2u; ki[j] = 64u * UCOLS * 2u; } }
#pragma unroll
    for (int j = 0; j < 2; ++j) { const int pos = 1024 * (2 * wid + j) + 16 * lane, st = pos >> 9, kk = (st >> 2) * 8 + ((pos & 511) >> 6), c = (st & 3) * 32 + ((pos & 63) >> 4) * 8;
        const int k = (kk & ~0xC) | ((kk & 4) << 1) | ((kk & 8) >> 1);
        vo[j] = (unsigned)WS_KV + (unsigned)((tb + k) * KVCOLS + h * 256 + 128 + c) * 2u; }
    const int vb0 = (int)(uintptr_t)V_lds + v_rd_base(lane);
    int koff[4];
#pragma unroll
    for (int dd = 0; dd < 4; ++dd) koff[dd] = kswz(r32, (dd * 16 + hi * 8) * 2);
    LAS unsigned char* ldsK = (LAS unsigned char*)K_lds + wid * 3072; LAS unsigned char* ldsV = (LAS unsigned char*)V_lds + wid * 2048;
#define DMAK(bo_) do { _Pragma("unroll") for (int j_ = 0; j_ < 3; ++j_) { \
        __builtin_amdgcn_global_load_lds((const unsigned*)(ws + ko[j_]), (LAS unsigned*)(ldsK + (bo_) + j_ * 1024), 16, 0, 0); ko[j_] += ki[j_]; } } while (0)
#define DMAV(bo_) do { _Pragma("unroll") for (int j_ = 0; j_ < 2; ++j_) { \
        __builtin_amdgcn_global_load_lds((const unsigned*)(ws + vo[j_]), (LAS unsigned*)(ldsV + (bo_) + j_ * 1024), 16, 0, 0); vo[j_] += 64u * KVCOLS * 2u; } } while (0)
#define VMW0() asm volatile("s_waitcnt vmcnt(0)" ::: "memory")
    float m_reg = -1e30f, l_reg = 0.f; f32x16 o[4] = {};
    DMAK(0); DMAV(0); DMAK(SHM_K);
    VMW0(); MBAR();
    if (grp == 1) MBAR();
    int kcur = 0, kp2 = 2 * SHM_K;
    int vcur = 0, vnext = SHM_V;
    bf16x8 pa0, pa1, pa2, pa3; f32x16 p0, p1;
#define VALU_HALF(t) do { \
        SBAR(); if ((t) + 2 < NT) DMAK(kp2); if ((t) + 1 < NT) DMAV(vnext); SBAR(); \
        if (64 * (t) + 63 > qlo) { const int dq = qlo + r32 - 4 * hi - 64 * (t); const float NEG = -__builtin_inff(); \
            _Pragma("unroll") for (int r = 0; r < 16; ++r) { const int c = (r & 3) + 8 * (r >> 2); if (dq - c < 0) p0[r] = NEG; if (dq - c - 32 < 0) p1[r] = NEG; } } \
        float pmax = p0[0]; \
        _Pragma("unroll") for (int r = 1; r < 16; ++r) pmax = fmaxf(pmax, p0[r]); \
        _Pragma("unroll") for (int r = 0; r < 16; ++r) pmax = fmaxf(pmax, p1[r]); \
        { auto rr = __builtin_amdgcn_permlane32_swap(__float_as_uint(pmax), __float_as_uint(pmax), false, false); pmax = fmaxf(__uint_as_float(rr[0]), __uint_as_float(rr[1])); } \
          \
        const bool grow_ = __any(pmax > m_reg + 8.0f); \
        const float mn = grow_ ? fmaxf(m_reg, pmax) : m_reg; const float alpha = grow_ ? __builtin_amdgcn_exp2f(m_reg - mn) : 1.0f; m_reg = mn; \
        float ps = 0.f; \
        _Pragma("unroll") for (int r = 0; r < 16; ++r) { p0[r] = __builtin_amdgcn_exp2f(p0[r] - mn); ps += p0[r]; } \
        _Pragma("unroll") for (int r = 0; r < 16; ++r) { p1[r] = __builtin_amdgcn_exp2f(p1[r] - mn); ps += p1[r]; } \
        { auto rr = __builtin_amdgcn_permlane32_swap(__float_as_uint(ps), __float_as_uint(ps), false, false); ps = __uint_as_float(rr[0]) + __uint_as_float(rr[1]); } \
        l_reg = l_reg * alpha + ps; \
        PK4(p0, 0, pa0); PK4(p0, 8, pa1); PK4(p1, 0, pa2); PK4(p1, 8, pa3); \
        if (grow_) { if (hi == 0) al_l[r32] = alpha; asm volatile("s_waitcnt lgkmcnt(0)" ::: "memory"); \
            _Pragma("unroll") for (int d_ = 0; d_ < 4; ++d_) _Pragma("unroll") for (int r = 0; r < 16; ++r) o[d_][r] *= al_l[crow(r, hi)]; } \
        MBAR(); } while (0)
    qkt(p0, p1, K_lds + kcur, koff, qr);
    VMW0(); MBAR();
    for (int t = 0; t + 1 < NT; ++t) {
        VALU_HALF(t);
        kcur = (kcur == 2 * SHM_K) ? 0 : kcur + SHM_K; kp2 = (kp2 == 2 * SHM_K) ? 0 : kp2 + SHM_K;
        pv_tile(o, vb0 + vcur, pa0, pa1, pa2, pa3);
        qkt(p0, p1, K_lds + kcur, koff, qr);
        VMW0(); MBAR();
        vcur = vnext; vnext = (vnext == 2 * SHM_V) ? 0 : vnext + SHM_V;
    }
    VALU_HALF(NT - 1);
    pv_tile(o, vb0 + vcur, pa0, pa1, pa2, pa3);
    MBAR();
    if (grp == 0) MBAR();
#undef VALU_HALF
#undef DMAK
#undef DMAV
#undef VMW0
    { int le = lane; asm volatile("" : "+v"(le)); const int r32e = le & 31, hie = le >> 5;
      if (hie == 0) li_l[r32e] = l_reg; asm volatile("s_waitcnt lgkmcnt(0)" ::: "memory");
#pragma unroll
      for (int r = 0; r < 16; ++r) { const size_t row = tb + qlo + crow(r, hie); const float rl = __builtin_amdgcn_rcpf(li_l[crow(r, hie)]);
#pragma unroll
        for (int d0 = 0; d0 < 4; ++d0) { const int col = h * 128 + d0 * 32 + r32e;
            const float g = bf2f(U[row * UCOLS + 1088 + col]);
            OG[row * DM + col] = f2bf(o[d0][r] * rl * silu_f(g)); } } }
    MBAR();
}
__device__ __forceinline__ void phase(unsigned char* ws, char* lds, int wid) {
    const int G = gridDim.x, bx = blockIdx.x; const int vcu = (G % 8 == 0) ? (bx % 8) * (G / 8) + bx / 8 : bx;
    int grp;
    { unsigned* cnt = (unsigned*)(lds + OFF_WS + 2048);
      const int lane0 = lane_id();
      if (wid == 0 && lane0 < 4) cnt[lane0] = 0u;
      __syncthreads();
      const unsigned simd = (unsigned)__builtin_amdgcn_s_getreg((1 << 11) | (4 << 6) | 4) & 3u;
      unsigned g = 0u; if (lane0 == 0) g = atomicAdd(&cnt[simd], 1u);
      grp = (int)(__builtin_amdgcn_readfirstlane(g) & 1u);
      __syncthreads(); }
    for (int L = vcu; L < 1024; L += G) { const int bh = L >> 5, x = L & 31;
        for (int pass = 0; pass < 2; ++pass) block(bh >> 4, bh & 15, pass ? x : 63 - x, ws, lds, grp, wid);     }
}
}

namespace dil {
__device__ __forceinline__ void wave_item(int w, int gi, const bf16* Gb, const float* gqn, const float* gkn, bf16* OP, float* LSE, char* wlds, int lane) {
    const int r32 = lane & 31, hi = lane >> 5;
    const int sb = w & 511, grp = w >> 9, br = grp % 3, hh = (grp / 3) & 3, b = grp / 12;
    const int dsh = 2 * br, d = 1 << dsh;
    const int nblk = 512 >> dsh, res = sb / nblk, blk = sb % nblk, n0 = blk * 32;
    const size_t tb = (size_t)b * SEQ;
    const int hcol = hh * 1152 + br * 128;
    float* rk_l = (float*)(wlds + 8192); float* al_l = rk_l + 32; float* li_l = al_l + 32;
    const int vb0 = (int)(uintptr_t)wlds + v_rd_base(lane);
    bf16x8 qr[8];
    { const bf16* qp = Gb + (tb + (size_t)(n0 + r32) * d + res) * GCOLS + hcol + hi * 8;
#pragma unroll
      for (int d0 = 0; d0 < 8; ++d0) qr[d0] = *(const bf16x8*)(qp + d0 * 16); }
    const int hg = gi * 4 + hh;
    const float ab = exp2f(-0.5f * (float)(hg + 1)) * (float)d * LOG2E;
    float m_reg = -1e30f, l_reg = 0.f; f32x16 o[4] = {};
    const int jfirst = n0 >= 128 ? 0 : ((128 - n0) >> 5);
    const bf16* kcol = Gb + hcol + 384 + hi * 8; const bf16* vcol = Gb + hcol + 768 + (lane & 15) * 8;
    bf16x8 kf[8]; u32x4 vv[8];
#define DIL_LOAD(j_) do { const int kb_ = n0 - 128 + 32 * (j_); \
        { int nk = kb_ + r32; nk = nk < 0 ? 0 : nk; const bf16* kp = kcol + (tb + (size_t)nk * d + res) * GCOLS; \
          _Pragma("unroll") for (int d0 = 0; d0 < 8; ++d0) kf[d0] = *(const bf16x8*)(kp + d0 * 16); } \
        _Pragma("unroll") for (int i = 0; i < 8; ++i) { int nk = kb_ + (lane >> 4) + 4 * i; nk = nk < 0 ? 0 : nk; \
            vv[i] = *(const u32x4*)(vcol + (tb + (size_t)nk * d + res) * GCOLS); } } while (0)
    DIL_LOAD(jfirst);
    for (int j = jfirst; j < 5; ++j) {
        const int kbase = n0 - 128 + 32 * j;
#pragma unroll
        for (int i = 0; i < 8; ++i) *(u32x4*)(wlds + v_st((lane >> 4) + 4 * i, (lane & 15) * 8)) = vv[i];
        f32x16 p0 = f32x16{};
#pragma unroll
        for (int d0 = 0; d0 < 8; ++d0) p0 = __builtin_amdgcn_mfma_f32_32x32x16_bf16(kf[d0], qr[d0], p0, 0, 0, 0);
        SBAR();
        if (j + 1 < 5) DIL_LOAD(j + 1);
        SBAR();
        asm volatile("s_waitcnt lgkmcnt(0)" ::: "memory");
        const float NEG = -__builtin_inff();
        float pmax = NEG;
#pragma unroll
        for (int r = 0; r < 16; ++r) { const int kc = crow(r, hi); const int nk = kbase + kc; const int rel = n0 + r32 - nk;
            float sv = p0[r] - ab * (float)rel;
            if (rel < 0 || rel > 128 || nk < 0) sv = NEG;
            p0[r] = sv; pmax = fmaxf(pmax, sv); }
        { auto rr = __builtin_amdgcn_permlane32_swap(__float_as_uint(pmax), __float_as_uint(pmax), false, false); pmax = fmaxf(__uint_as_float(rr[0]), __uint_as_float(rr[1])); }
        const float mn = fmaxf(m_reg, pmax); const float alpha = __builtin_amdgcn_exp2f(m_reg - mn); m_reg = mn;
        float ps = 0.f;
#pragma unroll
        for (int r = 0; r < 16; ++r) { p0[r] = __builtin_amdgcn_exp2f(p0[r] - mn); ps += p0[r]; }
        { auto rr = __builtin_amdgcn_permlane32_swap(__float_as_uint(ps), __float_as_uint(ps), false, false); ps = __uint_as_float(rr[0]) + __uint_as_float(rr[1]); }
        l_reg = l_reg * alpha + ps;
        bf16x8 pa0, pa1; PK4(p0, 0, pa0); PK4(p0, 8, pa1);
        if (__any(alpha < 1.f)) { if (hi == 0) al_l[r32] = alpha; asm volatile("s_waitcnt lgkmcnt(0)" ::: "memory");
#pragma unroll
            for (int d_ = 0; d_ < 4; ++d_)
#pragma unroll
                for (int r = 0; r < 16; ++r) o[d_][r] *= al_l[crow(r, hi)]; }
#define PV2(d0) do { s16x4 l0, l1, h0, h1; constexpr int b_ = (d0) * 512; \
        TRRD(l0, b_); TRRD(h0, b_ + 2048); TRRD(l1, b_ + 4096); TRRD(h1, b_ + 6144); \
        asm volatile("s_waitcnt lgkmcnt(0)" ::: "memory"); SBAR(); \
        o[d0] = __builtin_amdgcn_mfma_f32_32x32x16_bf16(pa0, (bf16x8){l0[0], l0[1], l0[2], l0[3], h0[0], h0[1], h0[2], h0[3]}, o[d0], 0, 0, 0);   \
        o[d0] = __builtin_amdgcn_mfma_f32_32x32x16_bf16(pa1, (bf16x8){l1[0], l1[1], l1[2], l1[3], h1[0], h1[1], h1[2], h1[3]}, o[d0], 0, 0, 0); } while (0)
        PV2(0); PV2(1); PV2(2); PV2(3);
#undef PV2
    }
#undef DIL_LOAD
    if (hi == 0) { li_l[r32] = l_reg; LSE[((size_t)br * NTOK + tb + (size_t)(n0 + r32) * d + res) * 4 + hh] = m_reg + __builtin_amdgcn_logf(l_reg); }
    asm volatile("s_waitcnt lgkmcnt(0)" ::: "memory");
    bf16* op = OP + (size_t)br * NTOK * 512;
    float rl[16];
#pragma unroll
    for (int r = 0; r < 16; ++r) rl[r] = __builtin_amdgcn_rcpf(li_l[crow(r, hi)]);
    asm volatile("s_waitcnt lgkmcnt(0)" ::: "memory");
#pragma unroll
    for (int r = 0; r < 16; ++r) { const int qc = crow(r, hi);
#pragma unroll
        for (int d0 = 0; d0 < 4; ++d0) *(unsigned short*)(wlds + qc * 272 + (d0 * 32 + r32) * 2) = f2bf(o[d0][r] * rl[r]); }
    asm volatile("s_waitcnt lgkmcnt(0)" ::: "memory");
#pragma unroll
    for (int i = 0; i < 8; ++i) { const int q = (lane >> 4) + 4 * i; const u32x4 v = *(const u32x4*)(wlds + q * 272 + (lane & 15) * 16);
        const size_t row = tb + (size_t)(n0 + q) * d + res; *(u32x4*)(op + row * 512 + hh * 128 + (lane & 15) * 8) = v; }
    asm volatile("s_waitcnt lgkmcnt(0)" ::: "memory");
}
}

__global__ void __launch_bounds__(512, 2) yoco_fwd(Args args) {
    extern __shared__ __attribute__((aligned(16))) unsigned char lds[];
    cg::grid_group grid = cg::this_grid();
    const int wave = __builtin_amdgcn_readfirstlane((int)threadIdx.x >> 6);
#define lane lane_id()
    const int G = gridDim.x; const int gw = blockIdx.x * 8 + wave, ngw = G * 8;
    unsigned char* ws = args.ws;
    const int lo = args.ph_lo, hi = args.ph_hi;
#define IN(k) (lo <= (k) && (k) < hi)
#define SEAM(k) do { if ((k) + 1 < hi) grid.sync(); } while (0)
    if (IN(0)) {
      for (int rep = 0; rep < (DUP == 100 ? 2 : 1); ++rep) {
        LAS float* scr = (LAS float*)((LAS unsigned char*)lds + wave * 16384);
        int base = 0;
#define TR_MAT(Wp, Kc, Nc, Gp, Tp, Mp) do { const int ni = ((Kc) / 64) * ((Nc) / 32); int first = (gw - base) % ngw; if (first < 0) first += ngw; \
            for (int it = first; it < ni; it += ngw) transpose_item((Wp), (Kc), (Nc), (Gp), (Tp), (Mp), scr, it, lane); base += ni; } while (0)
        TR_MAT(args.in[2], 2048, 3136, args.in[1], (bf16*)(ws + WS_WAIN), 0);
        TR_MAT(args.in[4], 512, 3072, args.in[3], (bf16*)(ws + WS_WQUP), 0);
        TR_MAT(args.in[6], 512, 4096, args.in[5], (bf16*)(ws + WS_WKVUP), 0);
        TR_MAT(args.in[9], 2048, 2048, (const float*)nullptr, (bf16*)(ws + WS_WAO), 0);
        TR_MAT(args.in[11], 2048, 12288, args.in[10], (bf16*)(ws + WS_WBALL), 1);
        TR_MAT(args.in[14], 2048, 8192, args.in[13], (bf16*)(ws + WS_WBALL), 2);
        TR_MAT(args.in[16], 2048, 2048, (const float*)nullptr, (bf16*)(ws + WS_WBO), 0);
#undef TR_MAT
        if (NTOK % (4 * ngw) == 0) { for (int m = gw; m < NTOK; m += 4 * ngw) norm_row4_nt<true>(args.in[0] + (size_t)m * DM, (bf16*)(ws + WS_XN) + (size_t)m * DM, (size_t)ngw * DM, lane); }
        else { for (int m = gw; m < NTOK; m += ngw) norm_row(args.in[0] + (size_t)m * DM, (bf16*)(ws + WS_XN) + (size_t)m * DM, lane); }
        { float* COS = (float*)(ws + WS_ROPE); float* SIN = COS + SEQ * 32;
          for (int idx = gw * 64 + lane; idx < SEQ * 32; idx += ngw * 64) { float c, sn; sincos_pos(idx >> 5, idx & 31, c, sn); COS[idx] = c; SIN[idx] = sn; } }
      }
        SEAM(0);
    }
    if (IN(1)) {
        const pg8::Gemm g{(bf16*)(ws + WS_XN), (bf16*)(ws + WS_WAIN), NTOK, UCOLS, 2048, 2048};
        const pg8::EpiSt E{(bf16*)(ws + WS_U), UCOLS, 1 << 30, nullptr, 0, 0};
        pg8::StaticOrder S; S.init(g.M, g.N, G, (int)blockIdx.x);
#ifndef SK_G1
        for (int rep = 0; rep < (DUP == 1 ? 2 : 1); ++rep)
        pg8::gemm_phase<pg8::EpiSt, pg8::StaticOrder, true, true, 2048, 2048>((LAS unsigned char*)lds, g, S, E, wave);
#endif
        SEAM(1);
    }
    if (IN(2)) {
        for (int cj = 0; cj < (DUP == 2 ? 4 : 2); ++cj) { const int ci = cj & 1;
            const pg8::Gemm g{(bf16*)(ws + WS_U) + (ci ? 512 : 0), (bf16*)(ws + (ci ? WS_WKVUP : WS_WQUP)), NTOK, ci ? KVCOLS : QCOLS, 512, UCOLS};
            const pg8::EpiSt E{(bf16*)(ws + (ci ? WS_KV : WS_Q)), ci ? KVCOLS : QCOLS, 1 << 30, nullptr, 0, 0};
            pg8::StaticOrder S; S.init(g.M, g.N, G, (int)blockIdx.x);
#ifndef SK_G1
            pg8::gemm_phase<pg8::EpiSt, pg8::StaticOrder, true, true, 512, UCOLS>((LAS unsigned char*)lds, g, S, E, wave);
#endif
        }
        SEAM(2);
    }
    if (IN(3)) {
#ifndef SK_QKN
        { int l3 = lane; asm volatile("" : "+v"(l3)); qknorm_phase(ws, args.in[7], args.in[8], gw, ngw, l3); }
#endif
        SEAM(3);
    }
    if (IN(4)) {
#ifndef SK_MLA
        for (int rep = 0; rep < (DUP == 4 ? 2 : 1); ++rep) mla::phase(ws, (char*)lds, wave);
#endif
        SEAM(4);
    }
    if (IN(5)) {
        const pg8::Gemm g{(bf16*)(ws + WS_XN), (bf16*)(ws + WS_WAO), NTOK, DM, 2048, 2048};
        const pg8::EpiRes E{args.in[0], args.out, DM, true, false};
        pg8::StaticOrder S; S.init(g.M, g.N, G, (int)blockIdx.x);
#ifndef SK_G2
        for (int rep = 0; rep < (DUP == 5 ? 2 : 1); ++rep)
        pg8::gemm_phase<pg8::EpiRes, pg8::StaticOrder, true, true, 2048, 2048>((LAS unsigned char*)lds, g, S, E, wave);
#endif
        SEAM(5);
    }
    if (IN(6)) {
        if (DUP == 66) { for (int rep = 0; rep < 20; ++rep) grid.sync(); }
        for (int rep = 0; rep < (DUP == 6 ? 2 : 1); ++rep)
        if (NTOK % (4 * ngw) == 0) { for (int m = gw; m < NTOK; m += 4 * ngw) norm_row4_nt<false>(args.out + (size_t)m * DM, (bf16*)(ws + WS_XN) + (size_t)m * DM, (size_t)ngw * DM, lane); }
        else { for (int m = gw; m < NTOK; m += ngw) norm_row(args.out + (size_t)m * DM, (bf16*)(ws + WS_XN) + (size_t)m * DM, lane); }
        SEAM(6);
    }
    for (int it = 0; it < (DUP == 7 ? 8 : 4); ++it) { const int gi = it & 3;
        if (IN(7 + 3 * gi)) {
            const pg8::Gemm g{(bf16*)(ws + WS_XN), (bf16*)(ws + WS_WBALL) + (size_t)gi * GN * 2048, NTOK, GN, 2048, 2048};
            const pg8::EpiStNorm E{(bf16*)(ws + WS_G), GCOLS, 18, (bf16*)(ws + WS_GATE), DM, gi * 512, args.in[15], args.in[12], (LAS float*)((LAS unsigned char*)lds + 131072), QSCALE_B, EPSN};
            pg8::StaticOrder S; S.init(g.M, g.N, G, (int)blockIdx.x);
#ifndef SK_G1
            pg8::gemm_phase<pg8::EpiStNorm, pg8::StaticOrder, true, true, 2048, 2048>((LAS unsigned char*)lds, g, S, E, wave);
#endif
            SEAM(7 + 3 * gi);
        }
        if (IN(8 + 3 * gi)) {
#ifndef SK_DIL
            int lane2 = lane; asm volatile("" : "+v"(lane2));
            char* wlds = (char*)lds + wave * 16384;
            const int gwx = (G % 8 == 0) ? ((int)(blockIdx.x & 7) * (G / 8) + (int)(blockIdx.x >> 3)) * 8 + wave : gw;
            for (int rep = 0; rep < (DUP == 8 ? 2 : 1); ++rep)
            for (int w = gwx; w < 12288; w += ngw)
                dil::wave_item(w, gi, (const bf16*)(ws + WS_G), args.in[15], args.in[12], (bf16*)(ws + WS_OP), (float*)(ws + WS_LSE), wlds, lane2);
#endif
            SEAM(8 + 3 * gi);
        }
        if (IN(9 + 3 * gi)) {
            int lane2 = lane; asm volatile("" : "+v"(lane2));
            const int hh = lane2 >> 4, e0 = 8 * (lane2 & 15);
            const bf16* OP = (const bf16*)(ws + WS_OP); const float* LSE = (const float*)(ws + WS_LSE);
            const bf16* GATE = (const bf16*)(ws + WS_GATE); bf16* OG = (bf16*)(ws + WS_OG);
            for (int t0 = gw; t0 < NTOK; t0 += 4 * ngw) {
                float ls[4][3]; u32x4 ov[4][3], gv[4]; size_t oc[4]; bool ok[4];
#pragma unroll
                for (int k = 0; k < 4; ++k) { const int t = t0 + k * ngw; ok[k] = t < NTOK; const int tc = ok[k] ? t : t0;
                    oc[k] = (size_t)tc * DM + (gi * 4 + hh) * 128 + e0;
#pragma unroll
                    for (int br = 0; br < 3; ++br) { ls[k][br] = __builtin_nontemporal_load(LSE + ((size_t)br * NTOK + tc) * 4 + hh); ov[k][br] = __builtin_nontemporal_load((const u32x4*)(OP + ((size_t)br * NTOK + tc) * 512 + hh * 128 + e0)); }
                    gv[k] = __builtin_nontemporal_load((const u32x4*)(GATE + oc[k])); }
#pragma unroll
                for (int k = 0; k < 4; ++k) {
                    const float mx = fmaxf(ls[k][0], fmaxf(ls[k][1], ls[k][2]));
                    float w0 = __builtin_amdgcn_exp2f(ls[k][0] - mx), w1 = __builtin_amdgcn_exp2f(ls[k][1] - mx), w2 = __builtin_amdgcn_exp2f(ls[k][2] - mx);
                    const float inv = __builtin_amdgcn_rcpf(w0 + w1 + w2); w0 *= inv; w1 *= inv; w2 *= inv;
                    u32x4 res;
#pragma unroll
                    for (int j = 0; j < 4; ++j) {
                        const float a = w0 * bflo(ov[k][0][j]) + w1 * bflo(ov[k][1][j]) + w2 * bflo(ov[k][2][j]);
                        const float c = w0 * bfhi(ov[k][0][j]) + w1 * bfhi(ov[k][1][j]) + w2 * bfhi(ov[k][2][j]);
                        res[j] = cvtpk(a * silu_f(bflo(gv[k][j])), c * silu_f(bfhi(gv[k][j]))); }
                    if (ok[k]) *(u32x4*)(OG + oc[k]) = res; }
            }
            if (gi == 3) SEAM(9 + 3 * gi);
        }
    }
    if (IN(19)) {
        const pg8::Gemm g{(bf16*)(ws + WS_OG), (bf16*)(ws + WS_WBO), NTOK, DM, 2048, 2048};
        const pg8::EpiRes E{args.out, args.out, DM, true, true};
        pg8::StaticOrder S; S.init(g.M, g.N, G, (int)blockIdx.x);
#ifndef SK_G2
        pg8::gemm_phase<pg8::EpiRes, pg8::StaticOrder, true, true, 2048, 2048>((LAS unsigned char*)lds, g, S, E, wave);
#endif
    }
#undef IN
#undef SEAM
#undef lane
}

#ifndef ONE_LAUNCH
#define ONE_LAUNCH 1
#endif
extern "C" void kernel_launch(void* const* d_in, const int* in_sizes, int n_in, void* d_out, int out_size, void* d_ws, size_t ws_size, hipStream_t stream) {
    static int grid = 0;
    if (grid == 0) {
        if (n_in != 17 || in_sizes[0] != NTOK * DM || out_size != NTOK * DM || ws_size < WS_END) {
            fprintf(stderr, "kernel_launch: unexpected shapes (n_in %d, in0 %d, out %d, ws %zu < %zu)\n", n_in, n_in > 0 ? in_sizes[0] : -1, out_size, ws_size, (size_t)WS_END); grid = -1; return; }
        int dev = 0, cus = 0, per_cu = 0;
        (void)hipGetDevice(&dev); (void)hipDeviceGetAttribute(&cus, hipDeviceAttributeMultiprocessorCount, dev);
        if (hipFuncSetAttribute((const void*)yoco_fwd, hipFuncAttributeMaxDynamicSharedMemorySize, LDS_BYTES) != hipSuccess) { fprintf(stderr, "kernel_launch: hipFuncSetAttribute failed\n"); grid = -1; return; }
        (void)hipOccupancyMaxActiveBlocksPerMultiprocessor(&per_cu, (const void*)yoco_fwd, 512, LDS_BYTES);
        (void)hipGetLastError();
        if (per_cu < 1) per_cu = 1;
        grid = cus > 0 ? cus : 256;
    }
    if (grid < 0) return;
    Args a{};
    for (int i = 0; i < 17; ++i) a.in[i] = (const float*)d_in[i];
    a.out = (float*)d_out; a.ws = (unsigned char*)d_ws;
#if ONE_LAUNCH
    a.ph_lo = 0; a.ph_hi = NPHASE;
    void* kargs[] = {&a};
    hipError_t e = hipLaunchCooperativeKernel((const void*)yoco_fwd, dim3(grid), dim3(512), kargs, LDS_BYTES, stream);
    if (e != hipSuccess) fprintf(stderr, "cooperative launch failed: %s (grid %d)\n", hipGetErrorString(e), grid);
#else
    for (int ph = 0; ph < NPHASE; ++ph) { a.ph_lo = ph; a.ph_hi = ph + 1;
        hipLaunchKernelGGL(yoco_fwd, dim3(grid), dim3(512), LDS_BYTES, stream, a); }
#endif
}
```

```cpp
#include <hip/hip_runtime.h>
#include <hip/hip_cooperative_groups.h>
#include <cstdio>
#include <cstdint>
namespace cg = cooperative_groups;
__device__ __forceinline__ int lane_id() { return (int)__builtin_amdgcn_mbcnt_hi(~0u, __builtin_amdgcn_mbcnt_lo(~0u, 0u)); }
namespace pg8 {
#define PG8_LAS __attribute__((address_space(3)))
typedef unsigned short bf16_t;
typedef short bf16x8 __attribute__((ext_vector_type(8)));
typedef float f32x4 __attribute__((ext_vector_type(4)));
typedef unsigned u32x4 __attribute__((ext_vector_type(4)));
constexpr int BM = 256, BK = 64, HALF = 128, HTB = HALF * BK * 2  , STAGE_BYTES = 8 * HTB, NXCD = 8, WGM = 4;

__host__ __device__ __forceinline__ int lds_byte(int r, int c) { const int st = (r >> 4) * 2 + (c >> 5), rr = r & 15, cc = c & 31, ob = rr * 64 + cc * 2; return st * 1024 + (ob ^ (((ob >> 9) & 1) << 5)); }
__host__ __device__ __forceinline__ void stage_rc(int b, int& R, int& C) { const int st = b / 1024, sb = b % 1024, swz = sb ^ (((sb >> 9) & 1) << 5); R = (st >> 1) * 16 + swz / 64; C = (st & 1) * 32 + (swz % 64) / 2; }
__host__ __device__ __forceinline__ int perm32(int rho) { const int n = rho >> 4, i = rho & 15; return 8 * (i >> 2) + 4 * n + (i & 3); }

struct Unit { int pm, pn; };
struct Gemm { const bf16_t* A; const bf16_t* Bt; int M, N, K, lda; };

struct StaticOrder {
    int nM, nN, nwg, G, c;
    __host__ __device__ void init(int M, int N, int G_, int c_) { nM = M / BM; nN = N / BM; nwg = nM * nN; G = G_; c = c_; }
    __host__ __device__ bool next(int i, Unit& u) const {
        const long L = (long)i * G + c; if (L >= nwg) return false;
        int wgid = (int)L; { const int q = nwg / NXCD, r = nwg % NXCD, xcd = wgid % NXCD, off = wgid / NXCD; wgid = (xcd < r ? xcd * (q + 1) : r * (q + 1) + (xcd - r) * q) + off; }
        const int nig = WGM * nN, gid = wgid / nig, fm = gid * WGM, gsz = (nM - fm) < WGM ? (nM - fm) : WGM;
        u.pm = fm + ((wgid % nig) % gsz); u.pn = (wgid % nig) / gsz; return true;
    }
    __device__ __forceinline__ void a_ready(const Unit&) const {}
    __device__ __forceinline__ void done(const Unit&) const {}
};

__device__ __forceinline__ unsigned cvt_pk_bf16(float lo, float hi) { unsigned r; asm volatile("v_cvt_pk_bf16_f32 %0, %1, %2" : "=v"(r) : "v"(lo), "v"(hi)); return r; }
template <class Epi, class Sched, bool ALIGN_EPI, bool SP2, int KC, int LDAC>
__device__ __forceinline__ void gemm_phase(PG8_LAS unsigned char* lds, const Gemm g, const Sched& S, const Epi& E, int wid_in) {
    const int wid = __builtin_amdgcn_readfirstlane(wid_in), lane = lane_id(), tid = wid * 64 + lane, wr = wid >> 2, wc = wid & 3, fr = lane & 15, fq = lane >> 4;
    constexpr int K = KC, nt = K / BK, lda = LDAC;
    unsigned voffA[2], voffB[2];
#pragma unroll
    for (int i = 0; i < 2; ++i) { int R, C; stage_rc(tid * 16 + i * 8192, R, C); const int Rb = Epi::PERM ? ((R & ~31) + perm32(R & 31)) : R;
        voffA[i] = (unsigned)(R * lda + C) * 2u; voffB[i] = (unsigned)(Rb * K + C) * 2u; }
    const size_t kstep = (size_t)(BK * 2);
    const size_t hstep = (size_t)HALF * K * 2;
    const size_t tstep = 2 * hstep; const size_t hstepA = (size_t)HALF * lda * 2, tstepA = 2 * hstepA;
    const unsigned ldsw = (unsigned)wid * 1024u;
    const int aoff = lds_byte(wr * 64 + fr, fq * 8), boff = lds_byte(wc * 32 + fr, fq * 8);
#define PG8_SA(b, h) (((b) * 2 + (h)) * HTB)
#define PG8_SB(b, h) ((4 + (b) * 2 + (h)) * HTB)
#define PG8_STAGE(bufoff, gbase, voff) do { _Pragma("unroll") for (int _i = 0; _i < 2; ++_i) \
        __builtin_amdgcn_global_load_lds((const unsigned*)((const char*)(gbase) + (voff)[_i]), (PG8_LAS unsigned*)(lds + (bufoff) + ldsw + _i * 8192), 16, 0, 0); } while (0)
#define PG8_LDA(dst, b, h) do { _Pragma("unroll") for (int m = 0; m < 4; ++m) _Pragma("unroll") for (int k = 0; k < 2; ++k) dst[m][k] = *(const PG8_LAS bf16x8*)(lds + PG8_SA(b, h) + aoff + m * 2048 + k * 1024); } while (0)
#define PG8_LDB(dst, b, h) do { _Pragma("unroll") for (int n = 0; n < 2; ++n) _Pragma("unroll") for (int k = 0; k < 2; ++k) dst[n][k] = *(const PG8_LAS bf16x8*)(lds + PG8_SB(b, h) + boff + n * 2048 + k * 1024); } while (0)
#define PG8_MMA(ai, bj, At, Bt) do { __builtin_amdgcn_s_setprio(1); _Pragma("unroll") for (int m = 0; m < 4; ++m) _Pragma("unroll") for (int n = 0; n < 2; ++n) _Pragma("unroll") for (int k = 0; k < 2; ++k) \
        acc[ai][bj][m][n] = __builtin_amdgcn_mfma_f32_16x16x32_bf16(Bt[n][k], At[m][k], acc[ai][bj][m][n], 0, 0, 0); __builtin_amdgcn_s_setprio(0); } while (0)
#define PG8_WAIT_V(n) asm volatile("s_waitcnt vmcnt(" #n ")" ::: "memory")
#define PG8_WAIT_L(n) asm volatile("s_waitcnt lgkmcnt(" #n ")" ::: "memory")
#define PG8_BAR __builtin_amdgcn_s_barrier()
#define PG8_SCHED __builtin_amdgcn_sched_barrier(0)
    Unit cur, nxt; int ui = 0;
    if (!S.next(0, cur)) return;
    f32x4 acc[2][2][4][2];
#pragma unroll
    for (int a = 0; a < 2; ++a)
#pragma unroll
        for (int b = 0; b < 2; ++b)
#pragma unroll
            for (int m = 0; m < 4; ++m)
#pragma unroll
                for (int n = 0; n < 2; ++n) acc[a][b][m][n] = (f32x4){0.f, 0.f, 0.f, 0.f};
    bf16x8 At[4][2], B0[2][2], B1[2][2];
    const char* cA = (const char*)g.A + (size_t)cur.pm * tstepA; const char* cB = (const char*)g.Bt + (size_t)cur.pn * tstep;
    S.a_ready(cur);
    if constexpr (SP2) {
        PG8_STAGE(PG8_SB(0, 0), cB, voffB); PG8_STAGE(PG8_SB(0, 1), cB + hstep, voffB); PG8_STAGE(PG8_SA(0, 0), cA, voffA); PG8_STAGE(PG8_SA(0, 1), cA + hstepA, voffA);
        if (wr == 1) PG8_BAR;
        PG8_WAIT_V(2); PG8_BAR;
        PG8_STAGE(PG8_SB(1, 0), cB + kstep, voffB); PG8_STAGE(PG8_SA(1, 0), cA + kstep, voffA); PG8_STAGE(PG8_SB(1, 1), cB + hstep + kstep, voffB);
        PG8_WAIT_V(6); PG8_BAR;
    } else {
        PG8_STAGE(PG8_SB(0, 0), cB, voffB); PG8_STAGE(PG8_SA(0, 0), cA, voffA); PG8_STAGE(PG8_SB(0, 1), cB + hstep, voffB); PG8_STAGE(PG8_SA(0, 1), cA + hstepA, voffA);
        if (wr == 1) PG8_BAR;
        PG8_WAIT_V(4); PG8_BAR;
        PG8_STAGE(PG8_SB(1, 0), cB + kstep, voffB); PG8_STAGE(PG8_SA(1, 0), cA + kstep, voffA); PG8_STAGE(PG8_SB(1, 1), cB + hstep + kstep, voffB);
        PG8_WAIT_V(6); PG8_BAR;
    }
    for (;;) {
        const bool has_next = S.next(ui + 1, nxt);
        const char* nA = has_next ? (const char*)g.A + (size_t)nxt.pm * tstepA : cA; const char* nB = has_next ? (const char*)g.Bt + (size_t)nxt.pn * tstep : cB;
        for (int t = 0; t < nt; t += 2) {
            const bool last = (t == nt - 2);
            const char* a1 = cA + (size_t)(t + 1) * kstep;
            const char* a2 = last ? nA : cA + (size_t)(t + 2) * kstep; const char* b2 = last ? nB : cB + (size_t)(t + 2) * kstep;
            const char* a3 = a2 + kstep; const char* b3 = b2 + kstep;
            if (last && has_next) S.a_ready(nxt);
            if constexpr (SP2) {
            PG8_LDB(B0, 0, 0); PG8_LDB(B1, 0, 1); PG8_SCHED; PG8_LDA(At, 0, 0); PG8_STAGE(PG8_SA(1, 1), a1 + hstepA, voffA);
            PG8_WAIT_V(8); PG8_WAIT_L(0); PG8_BAR; PG8_MMA(0, 0, At, B0); PG8_MMA(0, 1, At, B1); PG8_BAR; PG8_SCHED;
            PG8_LDA(At, 0, 1); PG8_STAGE(PG8_SB(0, 0), b2, voffB); PG8_STAGE(PG8_SB(0, 1), b2 + hstep, voffB); PG8_STAGE(PG8_SA(0, 0), a2, voffA);
            PG8_WAIT_V(8); PG8_WAIT_L(0); PG8_BAR; PG8_MMA(1, 0, At, B0); PG8_MMA(1, 1, At, B1); PG8_BAR; PG8_SCHED;
            PG8_LDB(B0, 1, 0); PG8_LDB(B1, 1, 1); PG8_SCHED; PG8_LDA(At, 1, 0); PG8_STAGE(PG8_SA(0, 1), a2 + hstepA, voffA);
            PG8_WAIT_V(8); PG8_WAIT_L(0); PG8_BAR; PG8_MMA(0, 0, At, B0); PG8_MMA(0, 1, At, B1); PG8_BAR; PG8_SCHED;
            PG8_LDA(At, 1, 1); PG8_STAGE(PG8_SB(1, 0), b3, voffB); PG8_STAGE(PG8_SB(1, 1), b3 + hstep, voffB); PG8_STAGE(PG8_SA(1, 0), a3, voffA);
            PG8_WAIT_V(8); PG8_WAIT_L(0); PG8_BAR; PG8_MMA(1, 0, At, B0); PG8_MMA(1, 1, At, B1); PG8_BAR; PG8_SCHED;
            } else {
            PG8_LDB(B0, 0, 0); PG8_SCHED; PG8_LDA(At, 0, 0); PG8_STAGE(PG8_SA(1, 1), a1 + hstepA, voffA);
            PG8_WAIT_L(8); PG8_BAR; PG8_WAIT_L(0); PG8_MMA(0, 0, At, B0); PG8_BAR; PG8_SCHED;
            PG8_LDB(B1, 0, 1); PG8_STAGE(PG8_SB(0, 0), b2, voffB);
            PG8_BAR; PG8_WAIT_L(0); PG8_MMA(0, 1, At, B1); PG8_BAR;
            PG8_LDA(At, 0, 1); PG8_STAGE(PG8_SA(0, 0), a2, voffA);
            PG8_BAR; PG8_WAIT_L(0); PG8_MMA(1, 0, At, B0); PG8_BAR; PG8_SCHED;
            PG8_STAGE(PG8_SB(0, 1), b2 + hstep, voffB);
            PG8_WAIT_V(6); PG8_BAR; PG8_MMA(1, 1, At, B1); PG8_BAR;
            PG8_LDB(B0, 1, 0); PG8_SCHED; PG8_LDA(At, 1, 0); PG8_STAGE(PG8_SA(0, 1), a2 + hstepA, voffA);
            PG8_WAIT_L(8); PG8_BAR; PG8_WAIT_L(0); PG8_MMA(0, 0, At, B0); PG8_BAR; PG8_SCHED;
            PG8_LDB(B1, 1, 1); PG8_STAGE(PG8_SB(1, 0), b3, voffB);
            PG8_BAR; PG8_WAIT_L(0); PG8_MMA(0, 1, At, B1); PG8_BAR;
            PG8_LDA(At, 1, 1); PG8_STAGE(PG8_SA(1, 0), a3, voffA);
            PG8_BAR; PG8_WAIT_L(0); PG8_MMA(1, 0, At, B0); PG8_BAR; PG8_SCHED;
            PG8_STAGE(PG8_SB(1, 1), b3 + hstep, voffB);
            PG8_WAIT_V(6); PG8_BAR; PG8_MMA(1, 1, At, B1); PG8_BAR;
            }
        }
        if constexpr (ALIGN_EPI) { if (wr == 0) PG8_BAR; }
        if constexpr (!Epi::AFTER_DRAIN) { E(acc, cur, wr, wc, fr, fq); S.done(cur); }
        if (!has_next) break;
#pragma unroll
        for (int a = 0; a < 2; ++a)
#pragma unroll
            for (int b = 0; b < 2; ++b)
#pragma unroll
                for (int m = 0; m < 4; ++m)
#pragma unroll
                    for (int n = 0; n < 2; ++n) acc[a][b][m][n] = (f32x4){0.f, 0.f, 0.f, 0.f};
        cur = nxt; cA = nA; cB = nB; ++ui;
        if constexpr (ALIGN_EPI) { if (wr == 1) PG8_BAR; }
    }
    PG8_WAIT_V(0);
    if constexpr (!ALIGN_EPI) { if (wr == 0) PG8_BAR; }
    PG8_BAR;
    if constexpr (Epi::AFTER_DRAIN) { E.fused(acc, cur, wr, wc, fr, fq, lds, wid, lane); S.done(cur); }
#undef PG8_SA
#undef PG8_SB
#undef PG8_STAGE
#undef PG8_LDA
#undef PG8_LDB
#undef PG8_MMA
#undef PG8_WAIT_V
#undef PG8_WAIT_L
#undef PG8_BAR
#undef PG8_SCHED
}
}

namespace pg8 {
struct EpiSt {
    static constexpr bool PERM = true, AFTER_DRAIN = false;
    bf16_t* O; int ldc; int ncut; bf16_t* O2; int ldc2; int col2;
    __device__ __forceinline__ void operator()(const f32x4 (&acc)[2][2][4][2], const Unit& u, int wr, int wc, int fr, int fq) const {
        const int row0 = u.pm * BM + wr * 64 + fr;
        bf16_t* base = O; int ld = ldc; int colt = u.pn * BM;
        if (u.pn >= ncut) { base = O2; ld = ldc2; colt = col2 + (u.pn - ncut) * BM; }
        const int col0 = colt + wc * 32 + 8 * fq;
#pragma unroll
        for (int ai = 0; ai < 2; ++ai)
#pragma unroll
            for (int m = 0; m < 4; ++m) { bf16_t* rowp = base + (size_t)(row0 + ai * HALF + m * 16) * ld + col0;
#pragma unroll
                for (int bj = 0; bj < 2; ++bj) { const f32x4 v0 = acc[ai][bj][m][0], v1 = acc[ai][bj][m][1];
                    u32x4 w; w.x = cvt_pk_bf16(v0[0], v0[1]); w.y = cvt_pk_bf16(v0[2], v0[3]); w.z = cvt_pk_bf16(v1[0], v1[1]); w.w = cvt_pk_bf16(v1[2], v1[3]);
                    *(u32x4*)(rowp + bj * HALF) = w; } }
    }
};
struct EpiStNorm {
    static constexpr bool PERM = true, AFTER_DRAIN = false;
    bf16_t* O; int ldc; int ncut; bf16_t* O2; int ldc2; int col2; const float* gq; const float* gk; PG8_LAS float* P; float qscale, eps;
    __device__ __forceinline__ void operator()(const f32x4 (&acc)[2][2][4][2], const Unit& u, int wr, int wc, int fr, int fq) const {
        const int row0 = u.pm * BM + wr * 64 + fr;
        const bool gate = u.pn >= ncut;
        bf16_t* base = O; int ld = ldc; int colt = u.pn * BM;
        if (gate) { base = O2; ld = ldc2; colt = col2 + (u.pn - ncut) * BM; }
        const int col0 = colt + wc * 32 + 8 * fq;
        int part[2], br[2];
#pragma unroll
        for (int bj = 0; bj < 2; ++bj) { const int rem = (u.pn * 2 + bj) % 9; part[bj] = gate ? 2 : rem / 3; br[bj] = rem % 3; }
        f32x4 cg[2][2];
#pragma unroll
        for (int bj = 0; bj < 2; ++bj) {
            cg[bj][0] = (f32x4){1.f, 1.f, 1.f, 1.f}; cg[bj][1] = cg[bj][0];
            if (part[bj] == 0) { const int e = br[bj] * 128 + wc * 32 + 8 * fq;
                cg[bj][0] = *(const f32x4*)(gq + e) * *(const f32x4*)(gk + e) * qscale; cg[bj][1] = *(const f32x4*)(gq + e + 4) * *(const f32x4*)(gk + e + 4) * qscale; } }
        float sc[2][2][4];
#pragma unroll
        for (int ai = 0; ai < 2; ++ai)
#pragma unroll
            for (int bj = 0; bj < 2; ++bj)
#pragma unroll
                for (int m = 0; m < 4; ++m) sc[ai][bj][m] = 1.f;
        if (part[0] < 2 || part[1] < 2) {
#pragma unroll
            for (int ai = 0; ai < 2; ++ai)
#pragma unroll
                for (int bj = 0; bj < 2; ++bj)
#pragma unroll
                    for (int m = 0; m < 4; ++m) if (part[bj] < 2) { const f32x4 a = acc[ai][bj][m][0], b = acc[ai][bj][m][1];
                        float q = (a[0] * a[0] + a[1] * a[1]) + (a[2] * a[2] + a[3] * a[3]) + (b[0] * b[0] + b[1] * b[1]) + (b[2] * b[2] + b[3] * b[3]);
                        { auto rr = __builtin_amdgcn_permlane16_swap(__float_as_uint(q), __float_as_uint(q), false, false); q = __uint_as_float(rr[0]) + __uint_as_float(rr[1]); }
                        { auto rr = __builtin_amdgcn_permlane32_swap(__float_as_uint(q), __float_as_uint(q), false, false); q = __uint_as_float(rr[0]) + __uint_as_float(rr[1]); }
                        if (fq == 0) P[(bj * 256 + ai * HALF + wr * 64 + m * 16 + fr) * 4 + wc] = q; }
            asm volatile("s_waitcnt lgkmcnt(0)\n\ts_barrier" ::: "memory");
#pragma unroll
            for (int ai = 0; ai < 2; ++ai)
#pragma unroll
                for (int bj = 0; bj < 2; ++bj)
#pragma unroll
                    for (int m = 0; m < 4; ++m) if (part[bj] < 2) { const f32x4 t = *(const PG8_LAS f32x4*)(P + (bj * 256 + ai * HALF + wr * 64 + m * 16 + fr) * 4);
                        sc[ai][bj][m] = __builtin_amdgcn_rsqf(((t[0] + t[1]) + (t[2] + t[3])) * (1.0f / 128.0f) + eps); }
        }
#pragma unroll
        for (int ai = 0; ai < 2; ++ai)
#pragma unroll
            for (int m = 0; m < 4; ++m) { bf16_t* rowp = base + (size_t)(row0 + ai * HALF + m * 16) * ld + col0;
#pragma unroll
                for (int bj = 0; bj < 2; ++bj) { const f32x4 v0 = acc[ai][bj][m][0] * cg[bj][0] * sc[ai][bj][m], v1 = acc[ai][bj][m][1] * cg[bj][1] * sc[ai][bj][m];
                    u32x4 w; w.x = cvt_pk_bf16(v0[0], v0[1]); w.y = cvt_pk_bf16(v0[2], v0[3]); w.z = cvt_pk_bf16(v1[0], v1[1]); w.w = cvt_pk_bf16(v1[2], v1[3]);
                    *(u32x4*)(rowp + bj * HALF) = w; } }
    }
};
struct EpiRes {
    static constexpr bool PERM = false, AFTER_DRAIN = false;
    const float* base; float* out; int ldc; bool nt_ld, nt_st;
    __device__ __forceinline__ void operator()(const f32x4 (&acc)[2][2][4][2], const Unit& u, int wr, int wc, int fr, int fq) const {
        const int col0 = u.pn * BM + wc * 32 + 4 * fq;
#pragma unroll
        for (int ai = 0; ai < 2; ++ai) {
            const size_t off0 = (size_t)(u.pm * BM + ai * HALF + wr * 64 + fr) * ldc + col0;
            f32x4 bs[4][2][2];
#pragma unroll
            for (int m = 0; m < 4; ++m)
#pragma unroll
                for (int bj = 0; bj < 2; ++bj)
#pragma unroll
                    for (int n = 0; n < 2; ++n) { const f32x4* p_ = (const f32x4*)(base + off0 + (size_t)m * 16 * ldc + bj * HALF + n * 16); bs[m][bj][n] = nt_ld ? __builtin_nontemporal_load(p_) : *p_; }
            asm volatile("" ::: "memory");
#pragma unroll
            for (int m = 0; m < 4; ++m)
#pragma unroll
                for (int bj = 0; bj < 2; ++bj)
#pragma unroll
                    for (int n = 0; n < 2; ++n) { f32x4* q_ = (f32x4*)(out + off0 + (size_t)m * 16 * ldc + bj * HALF + n * 16); const f32x4 r_ = bs[m][bj][n] + acc[ai][bj][m][n]; if (nt_st) __builtin_nontemporal_store(r_, q_); else *q_ = r_; }
            asm volatile("" ::: "memory");
        }
    }
};
}

constexpr int SEQ = 16384, NTOK = 32768, DM = 2048;
constexpr int UCOLS = 3328;
constexpr int QCOLS = 3072, KVCOLS = 4096, KRCOLS = 1024;
constexpr int GCOLS = 4608, GN = 5120;
constexpr float EPSN = 1e-6f;
constexpr float LOG2E = 1.4426950408889634f;
constexpr float QSCALE_A = 0.10411754627697264f;
constexpr float QSCALE_B = 0.12751743082459868f;
constexpr size_t MiB = 1u << 20;
constexpr size_t WS_WAIN = 0, WS_WQUP = 14 * MiB, WS_WKVUP = 17 * MiB, WS_WAO = 21 * MiB, WS_WBALL = 29 * MiB, WS_WBO = 109 * MiB;
constexpr size_t WS_LSE = 120 * MiB, WS_ROPE = 122 * MiB;
constexpr size_t WS_XN = 144 * MiB;
constexpr size_t WS_U = 272 * MiB, WS_Q = 480 * MiB, WS_KV = 672 * MiB, WS_KR = 928 * MiB;
constexpr size_t WS_G = 272 * MiB, WS_GATE = 560 * MiB, WS_OP = 688 * MiB, WS_OG = 784 * MiB;
constexpr size_t WS_END = 992 * MiB;
constexpr int LDS_BYTES = 147456;
constexpr int NPHASE = 20;
constexpr int DUP = 0;

typedef unsigned short bf16;
typedef short bf16x8 __attribute__((ext_vector_type(8)));
typedef short s16x4 __attribute__((ext_vector_type(4)));
typedef float f32x16 __attribute__((ext_vector_type(16)));
typedef float f32x4 __attribute__((ext_vector_type(4)));
typedef unsigned u32x4 __attribute__((ext_vector_type(4)));
typedef unsigned u32x2 __attribute__((ext_vector_type(2)));
#define LAS __attribute__((address_space(3)))

struct Args { const float* in[17]; float* out; unsigned char* ws; int ph_lo, ph_hi; };

__device__ __forceinline__ float bf2f(unsigned short h) { return __uint_as_float((unsigned)h << 16); }
__device__ __forceinline__ float bflo(unsigned w) { return __uint_as_float(w << 16); }
__device__ __forceinline__ float bfhi(unsigned w) { return __uint_as_float(w & 0xffff0000u); }
__device__ __forceinline__ unsigned cvtpk(float lo, float hi) { unsigned r; asm volatile("v_cvt_pk_bf16_f32 %0, %1, %2" : "=v"(r) : "v"(lo), "v"(hi)); return r; }
__device__ __forceinline__ unsigned short f2bf(float f) { return (unsigned short)(cvtpk(f, 0.f) & 0xffffu); }
__device__ __forceinline__ float wave_sum(float v) {
#pragma unroll
    for (int o = 1; o < 64; o <<= 1) v += __shfl_xor(v, o);
    return v;
}
__device__ __forceinline__ float silu_f(float g) { return g * __builtin_amdgcn_rcpf(1.f + __builtin_amdgcn_exp2f(g * -1.4426950408889634f)); }

__device__ __forceinline__ int dst_row(int map, int n0) {
    if (map == 0) return n0;
    if (map == 1) { const int part2 = n0 / 6144, r = n0 % 6144, br = r / 2048, h = (r % 2048) / 128, e = r % 128;
        return (h >> 2) * GN + (h & 3) * 1152 + (1 + part2) * 384 + br * 128 + e; }
    if (n0 < 6144) { const int br = n0 / 2048, h = (n0 % 2048) / 128, e = n0 % 128; return (h >> 2) * GN + (h & 3) * 1152 + br * 128 + e; }
    { const int c = n0 - 6144, h = c / 128, e = c % 128; return (h >> 2) * GN + GCOLS + (h & 3) * 128 + e; }
}
__device__ __forceinline__ void transpose_item(const float* W, int K, int N, const float* gain, bf16* WT, int map, LAS float* scr, int item, int lane) {
    const int nblk = N / 32, kb = item / nblk, nb = item % nblk, k0 = 64 * kb, n0 = 32 * nb;
    float wv[32];
#pragma unroll
    for (int i = 0; i < 32; ++i) wv[i] = __builtin_nontemporal_load(W + (size_t)(k0 + 2 * i + (lane >> 5)) * N + n0 + (lane & 31));
#pragma unroll
    for (int i = 0; i < 32; ++i) { const int kk = 2 * i + (lane >> 5); const float gsc = gain ? gain[k0 + kk] : 1.f;
        scr[kk * 33 + (lane & 31)] = wv[i] * gsc; }
    asm volatile("s_waitcnt lgkmcnt(0)" ::: "memory");
    const int c = lane & 7; const int d0 = dst_row(map, n0);
#pragma unroll
    for (int j = 0; j < 4; ++j) { const int n = (lane >> 3) + 8 * j; const LAS float* s = scr + (8 * c) * 33 + n;
        u32x4 o; o.x = cvtpk(s[0 * 33], s[1 * 33]); o.y = cvtpk(s[2 * 33], s[3 * 33]); o.z = cvtpk(s[4 * 33], s[5 * 33]); o.w = cvtpk(s[6 * 33], s[7 * 33]);
        *(u32x4*)(WT + (size_t)(d0 + n) * K + k0 + 8 * c) = o; }
    asm volatile("s_waitcnt lgkmcnt(0)" ::: "memory");
}
__device__ __forceinline__ void norm_row(const float* xrow, bf16* orow, int lane) {
    const f32x4* xr = (const f32x4*)xrow + lane;
    f32x4 v[8]; float s = 0.f;
#pragma unroll
    for (int j = 0; j < 8; ++j) { v[j] = xr[64 * j]; s += (v[j].x * v[j].x + v[j].y * v[j].y) + (v[j].z * v[j].z + v[j].w * v[j].w); }
    const float rstd = __builtin_amdgcn_rsqf(wave_sum(s) * (1.f / DM) + EPSN);
    u32x2* o8 = (u32x2*)orow + lane;
#pragma unroll
    for (int j = 0; j < 8; ++j) { u32x2 w; w.x = cvtpk(v[j].x * rstd, v[j].y * rstd); w.y = cvtpk(v[j].z * rstd, v[j].w * rstd); o8[64 * j] = w; }
}

template <bool NT_> __device__ __forceinline__ void norm_row2(const float* xa, bf16* oa, const float* xb, bf16* ob, int lane) {
    const f32x4* ra = (const f32x4*)xa + lane; const f32x4* rb = (const f32x4*)xb + lane;
    f32x4 va[8], vb[8]; float sa = 0.f, sb = 0.f;
#pragma unroll
    for (int j = 0; j < 8; ++j) { if (NT_) { va[j] = __builtin_nontemporal_load(ra + 64 * j); vb[j] = __builtin_nontemporal_load(rb + 64 * j); } else { va[j] = ra[64 * j]; vb[j] = rb[64 * j]; } }
#pragma unroll
    for (int j = 0; j < 8; ++j) { sa += (va[j].x * va[j].x + va[j].y * va[j].y) + (va[j].z * va[j].z + va[j].w * va[j].w);
                                  sb += (vb[j].x * vb[j].x + vb[j].y * vb[j].y) + (vb[j].z * vb[j].z + vb[j].w * vb[j].w); }
    const float rsa = __builtin_amdgcn_rsqf(wave_sum(sa) * (1.f / DM) + EPSN), rsb = __builtin_amdgcn_rsqf(wave_sum(sb) * (1.f / DM) + EPSN);
    u32x2* pa = (u32x2*)oa + lane; u32x2* pb = (u32x2*)ob + lane;
#pragma unroll
    for (int j = 0; j < 8; ++j) { u32x2 w; w.x = cvtpk(va[j].x * rsa, va[j].y * rsa); w.y = cvtpk(va[j].z * rsa, va[j].w * rsa); pa[64 * j] = w;
                                  u32x2 z; z.x = cvtpk(vb[j].x * rsb, vb[j].y * rsb); z.y = cvtpk(vb[j].z * rsb, vb[j].w * rsb); pb[64 * j] = z; }
}

template <bool NT_> __device__ __forceinline__ void norm_row4_nt(const float* x0, bf16* o0, size_t rstride, int lane) {
    f32x4 v[4][8]; float s[4] = {0.f, 0.f, 0.f, 0.f};
#pragma unroll
    for (int k = 0; k < 4; ++k) { const f32x4* r = (const f32x4*)(x0 + k * rstride) + lane;
#pragma unroll
        for (int j = 0; j < 8; ++j) v[k][j] = NT_ ? __builtin_nontemporal_load(r + 64 * j) : r[64 * j]; }
#pragma unroll
    for (int k = 0; k < 4; ++k)
#pragma unroll
        for (int j = 0; j < 8; ++j) s[k] += (v[k][j].x * v[k][j].x + v[k][j].y * v[k][j].y) + (v[k][j].z * v[k][j].z + v[k][j].w * v[k][j].w);
#pragma unroll
    for (int k = 0; k < 4; ++k) { const float rs = __builtin_amdgcn_rsqf(wave_sum(s[k]) * (1.f / DM) + EPSN); u32x2* p = (u32x2*)(o0 + k * rstride) + lane;
#pragma unroll
        for (int j = 0; j < 8; ++j) { u32x2 w; w.x = cvtpk(v[k][j].x * rs, v[k][j].y * rs); w.y = cvtpk(v[k][j].z * rs, v[k][j].w * rs); p[64 * j] = w; } }
}

__device__ __forceinline__ void sincos_pos(int s, int i, float& c, float& sn) {
    double inv = 1.0;
    if (i & 1) inv *= 0.7498942093324559; if (i & 2) inv *= 0.5623413251903491; if (i & 4) inv *= 0.31622776601683794; if (i & 8) inv *= 0.1; if (i & 16) inv *= 0.01;
    const double a = (double)s * inv;
    const double k = __builtin_rint(a * 0.15915494309189535);
    double r = __builtin_fma(-k, 6.283185307179586, a); r = __builtin_fma(-k, 2.4492935982947064e-16, r);
    const double r2 = r * r;
    double ps = -3.868170170630684e-23; ps = ps * r2 + 1.9572941063391263e-20; ps = ps * r2 - 8.22063524662433e-18; ps = ps * r2 + 2.8114572543455206e-15; ps = ps * r2 - 7.647163731819816e-13;
    ps = ps * r2 + 1.6059043836821613e-10; ps = ps * r2 - 2.505210838544172e-08; ps = ps * r2 + 2.7557319223985893e-06; ps = ps * r2 - 0.0001984126984126984; ps = ps * r2 + 0.008333333333333333;
    ps = ps * r2 - 0.16666666666666666; ps = ps * r2 + 1.0;
    double pc = -8.896791392450574e-22; pc = pc * r2 + 4.110317623312165e-19; pc = pc * r2 - 1.5619206968586225e-16; pc = pc * r2 + 4.779477332387385e-14; pc = pc * r2 - 1.1470745597729725e-11;
    pc = pc * r2 + 2.08767569878681e-09; pc = pc * r2 - 2.755731922398589e-07; pc = pc * r2 + 2.48015873015873e-05; pc = pc * r2 - 0.001388888888888889; pc = pc * r2 + 0.041666666666666664;
    pc = pc * r2 - 0.5; pc = pc * r2 + 1.0;
    sn = (float)(ps * r); c = (float)pc;
}
__device__ __forceinline__ void unpack8(const u32x4 a, float* f) {
#pragma unroll
    for (int j = 0; j < 4; ++j) { f[2 * j] = bflo(a[j]); f[2 * j + 1] = bfhi(a[j]); }
}
__device__ __forceinline__ u32x4 pack8f(const float* f) { u32x4 w; w.x = cvtpk(f[0], f[1]); w.y = cvtpk(f[2], f[3]); w.z = cvtpk(f[4], f[5]); w.w = cvtpk(f[6], f[7]); return w; }
__device__ __forceinline__ void qknorm_phase(unsigned char* ws, const float* gq, const float* gk, int gw, int ngw, int lane) {
    bf16* U = (bf16*)(ws + WS_U); bf16* Q = (bf16*)(ws + WS_Q); bf16* KV = (bf16*)(ws + WS_KV);
    const float* COS = (const float*)(ws + WS_ROPE); const float* SIN = COS + SEQ * 32;
    const int h = lane >> 2, part = lane & 3;
    for (int t = gw; t < NTOK; t += ngw) {
        const int s = t & (SEQ - 1);
        const float* gqp = gq; const float* gkp = gk; asm volatile("" : "+s"(gqp), "+s"(gkp));
        char* ub = (char*)(U + (size_t)t * UCOLS); char* qb = (char*)(Q + (size_t)t * QCOLS); char* kb = (char*)(KV + (size_t)t * KVCOLS);
        const unsigned oq = (unsigned)(h * 192 + part * 32) * 2u, oq1 = (unsigned)(h * 192 + 128 + part * 8) * 2u, ok = (unsigned)(h * 256 + part * 64) * 2u;
        const unsigned opeo = (unsigned)(1024 + part * 8) * 2u, okr = (unsigned)(h * 64 + part * 8) * 2u;
        bf16* urow = (bf16*)ub; bf16* qp = (bf16*)qb + h * 192; bf16* kp = (bf16*)(kb + ok);
        const u32x4 cqv = *(const u32x4*)(ub + 16u * (unsigned)lane);
        u32x4 qn[4];
#pragma unroll
        for (int i = 0; i < 4; ++i) qn[i] = *(const u32x4*)(qb + oq + 16u * i);
        const u32x4 qr1 = *(const u32x4*)(qb + oq1), qr2 = *(const u32x4*)(qb + oq1 + 64u);
        float cs[8], sn[8];
        { const char* cb_ = (const char*)(COS + s * 32); const char* sb_ = (const char*)(SIN + s * 32); unsigned ot = (unsigned)part * 32u; asm volatile("" : "+v"(ot));
          const f32x4 a = *(const f32x4*)(cb_ + ot), b = *(const f32x4*)(cb_ + ot + 16u), c = *(const f32x4*)(sb_ + ot), d = *(const f32x4*)(sb_ + ot + 16u);
#pragma unroll
          for (int j = 0; j < 4; ++j) { cs[j] = a[j]; cs[4 + j] = b[j]; sn[j] = c[j]; sn[4 + j] = d[j]; } }
        const u32x4 ckvv = *(const u32x4*)(ub + 1024u + 16u * (unsigned)lane);
        const u32x4 pe1 = *(const u32x4*)(ub + opeo), pe2 = *(const u32x4*)(ub + opeo + 64u);
        u32x4 kvv[8];
#pragma unroll
        for (int i = 0; i < 8; ++i) kvv[i] = *(const u32x4*)(kb + ok + 16u * i);
        float rstd_q;
        { float f[8]; unpack8(cqv, f); float q = 0.f;
#pragma unroll
          for (int j = 0; j < 8; ++j) q += f[j] * f[j];
          rstd_q = __builtin_amdgcn_rsqf(wave_sum(q) * (1.f / 512.f) + EPSN); }
        { float y[32], r1[8], r2[8]; float ssq = 0.f;
#pragma unroll
          for (int i = 0; i < 4; ++i) unpack8(qn[i], y + 8 * i);
          unpack8(qr1, r1); unpack8(qr2, r2);
#pragma unroll
          for (int j = 0; j < 32; ++j) ssq += y[j] * y[j];
#pragma unroll
          for (int j = 0; j < 8; ++j) ssq += r1[j] * r1[j] + r2[j] * r2[j];
          ssq += __shfl_xor(ssq, 1); ssq += __shfl_xor(ssq, 2);
          const float scq = rstd_q * (__builtin_amdgcn_rsqf(ssq * rstd_q * rstd_q * (1.f / 192.f) + EPSN)) * QSCALE_A;
#pragma unroll
          for (int i = 0; i < 8; ++i) { const f32x4 g = *(const f32x4*)(gqp + part * 32 + 4 * i);
#pragma unroll
              for (int j = 0; j < 4; ++j) y[4 * i + j] *= scq * g[j]; }
#pragma unroll
          for (int i = 0; i < 4; ++i) *(u32x4*)(qb + oq + 16u * i) = pack8f(y + 8 * i);
          float o1[8], o2[8];
#pragma unroll
          for (int i = 0; i < 2; ++i) { const f32x4 g1 = *(const f32x4*)(gqp + 128 + part * 8 + 4 * i), g2 = *(const f32x4*)(gqp + 160 + part * 8 + 4 * i);
#pragma unroll
              for (int j = 0; j < 4; ++j) { const int e = 4 * i + j; const float y1 = r1[e] * scq * g1[j], y2 = r2[e] * scq * g2[j];
                  o1[e] = y1 * cs[e] - y2 * sn[e]; o2[e] = y2 * cs[e] + y1 * sn[e]; } }
          *(u32x4*)(qb + oq1) = pack8f(o1); *(u32x4*)(qb + oq1 + 64u) = pack8f(o2); }
        __builtin_amdgcn_sched_barrier(0);
        float rstd_kv, ssq_pe;
        { float f[8]; unpack8(ckvv, f); float q = 0.f;
#pragma unroll
          for (int j = 0; j < 8; ++j) q += f[j] * f[j];
          rstd_kv = __builtin_amdgcn_rsqf(wave_sum(q) * (1.f / 512.f) + EPSN); }
        float x1[8], x2[8]; unpack8(pe1, x1); unpack8(pe2, x2);
        { float q = 0.f;
#pragma unroll
          for (int j = 0; j < 8; ++j) q += x1[j] * x1[j] + x2[j] * x2[j];
          q += __shfl_xor(q, 1); q += __shfl_xor(q, 2); ssq_pe = q; }
        { float ssq = 0.f;
#pragma unroll
          for (int i = 0; i < 8; ++i) { float f[8]; unpack8(kvv[i], f);
#pragma unroll
              for (int j = 0; j < 8; ++j) ssq += f[j] * f[j]; }
          ssq = part < 2 ? ssq : 0.f;
          ssq += __shfl_xor(ssq, 1); ssq += __shfl_xor(ssq, 2);
          const float rk = __builtin_amdgcn_rsqf((ssq * rstd_kv * rstd_kv + ssq_pe) * (1.f / 192.f) + EPSN);
          const float sck = part < 2 ? rstd_kv * rk : rstd_kv;
#pragma unroll
          for (int i = 0; i < 8; ++i) { float f[8]; unpack8(kvv[i], f);
              f32x4 g0 = *(const f32x4*)(gkp + (part & 1) * 64 + 8 * i), g1 = *(const f32x4*)(gkp + (part & 1) * 64 + 8 * i + 4);
              if (part >= 2) { g0 = (f32x4){1.f, 1.f, 1.f, 1.f}; g1 = g0; }
#pragma unroll
              for (int j = 0; j < 4; ++j) { f[j] *= sck * g0[j]; f[4 + j] *= sck * g1[j]; }
              *(u32x4*)(kb + ok + 16u * i) = pack8f(f); }
          float o1[8], o2[8];
#pragma unroll
          for (int i = 0; i < 2; ++i) { const f32x4 g1 = *(const f32x4*)(gkp + 128 + part * 8 + 4 * i), g2 = *(const f32x4*)(gkp + 160 + part * 8 + 4 * i);
#pragma unroll
              for (int j = 0; j < 4; ++j) { const int e = 4 * i + j; const float y1 = x1[e] * rk * g1[j], y2 = x2[e] * rk * g2[j];
                  o1[e] = y1 * cs[e] - y2 * sn[e]; o2[e] = y2 * cs[e] + y1 * sn[e]; } }
          *(u32x4*)(ub + okr) = pack8f(o1); *(u32x4*)(ub + okr + 64u) = pack8f(o2); }
    }
}

#define SBAR() __builtin_amdgcn_sched_barrier(0)
__device__ __forceinline__ int v_st(int k, int c) { const int kk = (k & ~0xC) | ((k & 4) << 1) | ((k & 8) >> 1); return ((kk >> 3) * 4 + (c >> 5)) * 512 + ((kk & 7) * 32 + (c & 31)) * 2; }
__device__ __forceinline__ int v_rd_base(int lane) { return ((lane & 3) << 3) | (((lane >> 2) & 3) << 6) | (((lane >> 4) & 1) << 5) | (((lane >> 5) & 1) << 8); }
__device__ __forceinline__ int crow(int r, int hi) { return (r & 3) + 8 * (r >> 2) + 4 * hi; }
#define PK4(P, B_, OUT) do { unsigned a0 = cvtpk(P[B_+0], P[B_+1]), a1 = cvtpk(P[B_+2], P[B_+3]);                          \
        unsigned b0 = cvtpk(P[B_+4], P[B_+5]), b1 = cvtpk(P[B_+6], P[B_+7]);                                             \
        auto r0 = __builtin_amdgcn_permlane32_swap(a0, b0, false, false); auto r1 = __builtin_amdgcn_permlane32_swap(a1, b1, false, false); \
        u32x4 w = {r0[0], r1[0], r0[1], r1[1]}; OUT = *reinterpret_cast<bf16x8*>(&w); } while (0)
#define TRRD(dst, off) asm volatile("ds_read_b64_tr_b16 %0, %1 offset:%2" : "=&v"(dst) : "v"(vb0), "i"(off) : "memory")

namespace mla {
constexpr int SHM_V = 16384, SHM_K = 24576, OFF_K = 3 * SHM_V, OFF_WS = OFF_K + 3 * SHM_K;
__device__ __forceinline__ int kswz(int row, int colB) { return row * 384 + (colB ^ (((row >> 1) & 7) << 4)); }
#define MBAR() asm volatile("s_waitcnt lgkmcnt(0)\n\ts_barrier" ::: "memory")
__device__ __forceinline__ void qkt(f32x16& p0, f32x16& p1, const char* kbuf, const int* koff, const bf16x8* qr) {
    p0 = f32x16{}; p1 = f32x16{};
    int ka[4];
#pragma unroll
    for (int dd = 0; dd < 4; ++dd) ka[dd] = (int)(uintptr_t)kbuf + koff[dd];
    bf16x8 X0, X1, Y0, Y1, Z0, Z1;
#define KRD(S, s_) asm volatile("ds_read_b128 %0, %2 offset:%3\n\tds_read_b128 %1, %2 offset:%4" : "=&v"(S##0), "=&v"(S##1) : "v"(ka[(s_) & 3]), "i"(((s_) >> 2) * 128), "i"(((s_) >> 2) * 128 + 12288) : "memory")
#define KMM(S, s_) do { p0 = __builtin_amdgcn_mfma_f32_32x32x16_bf16(S##0, qr[s_], p0, 0, 0, 0); p1 = __builtin_amdgcn_mfma_f32_32x32x16_bf16(S##1, qr[s_], p1, 0, 0, 0); } while (0)
    KRD(X, 0); KRD(Y, 1);
    KRD(Z, 2); asm volatile("s_waitcnt lgkmcnt(4)" ::: "memory"); SBAR(); KMM(X, 0); SBAR();
    KRD(X, 3); asm volatile("s_waitcnt lgkmcnt(4)" ::: "memory"); SBAR(); KMM(Y, 1); SBAR();
    KRD(Y, 4); asm volatile("s_waitcnt lgkmcnt(4)" ::: "memory"); SBAR(); KMM(Z, 2); SBAR();
    KRD(Z, 5); asm volatile("s_waitcnt lgkmcnt(4)" ::: "memory"); SBAR(); KMM(X, 3); SBAR();
    KRD(X, 6); asm volatile("s_waitcnt lgkmcnt(4)" ::: "memory"); SBAR(); KMM(Y, 4); SBAR();
    KRD(Y, 7); asm volatile("s_waitcnt lgkmcnt(4)" ::: "memory"); SBAR(); KMM(Z, 5); SBAR();
    KRD(Z, 8); asm volatile("s_waitcnt lgkmcnt(4)" ::: "memory"); SBAR(); KMM(X, 6); SBAR();
    KRD(X, 9); asm volatile("s_waitcnt lgkmcnt(4)" ::: "memory"); SBAR(); KMM(Y, 7); SBAR();
    KRD(Y, 10); asm volatile("s_waitcnt lgkmcnt(4)" ::: "memory"); SBAR(); KMM(Z, 8); SBAR();
    KRD(Z, 11); asm volatile("s_waitcnt lgkmcnt(4)" ::: "memory"); SBAR(); KMM(X, 9); SBAR();
    asm volatile("s_waitcnt lgkmcnt(2)" ::: "memory"); SBAR(); KMM(Y, 10); SBAR();
    asm volatile("s_waitcnt lgkmcnt(0)" ::: "memory"); SBAR(); KMM(Z, 11); SBAR();
#undef KRD
#undef KMM
}
__device__ __forceinline__ void pv_tile(f32x16* o, int vb0, bf16x8 pa0, bf16x8 pa1, bf16x8 pa2, bf16x8 pa3) {
    s16x4 A0, A1, A2, A3, A4, A5, A6, A7, B0, B1, B2, B3, B4, B5, B6, B7;
#define RD8(S, d0) do { constexpr int b_ = (d0) * 512; TRRD(S##0, b_); TRRD(S##1, b_ + 2048); TRRD(S##2, b_ + 4096); TRRD(S##3, b_ + 6144); \
        TRRD(S##4, b_ + 8192); TRRD(S##5, b_ + 10240); TRRD(S##6, b_ + 12288); TRRD(S##7, b_ + 14336); } while (0)
#define MM4(S, d0) do { \
        o[d0] = __builtin_amdgcn_mfma_f32_32x32x16_bf16(pa0, (bf16x8){S##0[0], S##0[1], S##0[2], S##0[3], S##1[0], S##1[1], S##1[2], S##1[3]}, o[d0], 0, 0, 0); \
        o[d0] = __builtin_amdgcn_mfma_f32_32x32x16_bf16(pa1, (bf16x8){S##2[0], S##2[1], S##2[2], S##2[3], S##3[0], S##3[1], S##3[2], S##3[3]}, o[d0], 0, 0, 0); \
        o[d0] = __builtin_amdgcn_mfma_f32_32x32x16_bf16(pa2, (bf16x8){S##4[0], S##4[1], S##4[2], S##4[3], S##5[0], S##5[1], S##5[2], S##5[3]}, o[d0], 0, 0, 0); \
        o[d0] = __builtin_amdgcn_mfma_f32_32x32x16_bf16(pa3, (bf16x8){S##6[0], S##6[1], S##6[2], S##6[3], S##7[0], S##7[1], S##7[2], S##7[3]}, o[d0], 0, 0, 0); } while (0)
    RD8(A, 0);
    RD8(B, 1); asm volatile("s_waitcnt lgkmcnt(8)" ::: "memory"); SBAR(); MM4(A, 0); SBAR();
    RD8(A, 2); asm volatile("s_waitcnt lgkmcnt(8)" ::: "memory"); SBAR(); MM4(B, 1); SBAR();
    RD8(B, 3); asm volatile("s_waitcnt lgkmcnt(8)" ::: "memory"); SBAR(); MM4(A, 2); SBAR();
    asm volatile("s_waitcnt lgkmcnt(0)" ::: "memory"); SBAR(); MM4(B, 3);
#undef RD8
#undef MM4
}
__device__ __forceinline__ void block(int b, int h, int qb, unsigned char* ws, char* lds, int grp, int wid) {
    const bf16* Q = (const bf16*)(ws + WS_Q); const bf16* KV = (const bf16*)(ws + WS_KV); const bf16* KR = (const bf16*)(ws + WS_KR); const bf16* U = (const bf16*)(ws + WS_U); bf16* OG = (bf16*)(ws + WS_XN);
    const int lane = lane_id(), tid = wid * 64 + lane, r32 = lane & 31, hi = lane >> 5;
    const size_t tb = (size_t)b * SEQ;
    const int qlo = qb * 256 + wid * 32;
    char* V_lds = lds; char* K_lds = lds + OFF_K;
    float* wsf = (float*)(lds + OFF_WS) + wid * 64; float* li_l = wsf; float* al_l = wsf + 32;
    bf16x8 qr[12];
    { const bf16* qp = Q + (tb + qlo + r32) * QCOLS + h * 192 + hi * 8;
#pragma unroll
      for (int d0 = 0; d0 < 12; ++d0) qr[d0] = *(const bf16x8*)(qp + d0 * 16); }
    const int NT = (qb + 1) * 4;
    unsigned ko[3], ki[3], vo[2];
#pragma unroll
    for (int j = 0; j < 3; ++j) { const int pos = 1024 * (3 * wid + j) + 16 * lane, row = pos / 384, slot = (pos - row * 384) >> 4;
        const int ch = (slot & ~7) | ((slot & 7) ^ ((row >> 1) & 7));
        if (ch < 16) { ko[j] = (unsigned)WS_KV + (unsigned)((tb + row) * KVCOLS + h * 256 + ch * 8) * 2u; ki[j] = 64u * KVCOLS * 2u; }
        else { ko[j] = (unsigned)WS_U + (unsigned)((tb + row) * UCOLS + h * 64 + (ch - 16) * 8) * 2u; ki[j] = 64u * UCOLS * 2u; } }
#pragma unroll
    for (int j = 0; j < 2; ++j) { const int pos = 1024 * (2 * wid + j) + 16 * lane, st = pos >> 9, kk = (st >> 2) * 8 + ((pos & 511) >> 6), c = (st & 3) * 32 + ((pos & 63) >> 4) * 8;
        const int k = (kk & ~0xC) | ((kk & 4) << 1) | ((kk & 8) >> 1);
        vo[j] = (unsigned)WS_KV + (unsigned)((tb + k) * KVCOLS + h * 256 + 128 + c) * 2u; }
    const int vb0 = (int)(uintptr_t)V_lds + v_rd_base(lane);
    int koff[4];
#pragma unroll
    for (int dd = 0; dd < 4; ++dd) koff[dd] = kswz(r32, (dd * 16 + hi * 8) * 2);
    LAS unsigned char* ldsK = (LAS unsigned char*)K_lds + wid * 3072; LAS unsigned char* ldsV = (LAS unsigned char*)V_lds + wid * 2048;
#define DMAK(bo_) do { _Pragma("unroll") for (int j_ = 0; j_ < 3; ++j_) { \
        __builtin_amdgcn_global_load_lds((const unsigned*)(ws + ko[j_]), (LAS unsigned*)(ldsK + (bo_) + j_ * 1024), 16, 0, 0); ko[j_] += ki[j_]; } } while (0)
#define DMAV(bo_) do { _Pragma("unroll") for (int j_ = 0; j_ < 2; ++j_) { \
        __builtin_amdgcn_global_load_lds((const unsigned*)(ws + vo[j_]), (LAS unsigned*)(ldsV + (bo_) + j_ * 1024), 16, 0, 0); vo[j_] += 64u * KVCOLS * 2u; } } while (0)
#define VMW0() asm volatile("s_waitcnt vmcnt(0)" ::: "memory")
    float m_reg = -1e30f, l_reg = 0.f; f32x16 o[4] = {};
    DMAK(0); DMAV(0); DMAK(SHM_K);
    VMW0(); MBAR();
    if (grp == 1) MBAR();
    int kcur = 0, kp2 = 2 * SHM_K;
    int vcur = 0, vnext = SHM_V;
    bf16x8 pa0, pa1, pa2, pa3; f32x16 p0, p1;
#define VALU_HALF(t) do { \
        SBAR(); if ((t) + 2 < NT) DMAK(kp2); if ((t) + 1 < NT) DMAV(vnext); SBAR(); \
        if (64 * (t) + 63 > qlo) { const int dq = qlo + r32 - 4 * hi - 64 * (t); const float NEG = -__builtin_inff(); \
            _Pragma("unroll") for (int r = 0; r < 16; ++r) { const int c = (r & 3) + 8 * (r >> 2); if (dq - c < 0) p0[r] = NEG; if (dq - c - 32 < 0) p1[r] = NEG; } } \
        float pmax = p0[0]; \
        _Pragma("unroll") for (int r = 1; r < 16; ++r) pmax = fmaxf(pmax, p0[r]); \
        _Pragma("unroll") for (int r = 0; r < 16; ++r) pmax = fmaxf(pmax, p1[r]); \
        { auto rr = __builtin_amdgcn_permlane32_swap(__float_as_uint(pmax), __float_as_uint(pmax), false, false); pmax = fmaxf(__uint_as_float(rr[0]), __uint_as_float(rr[1])); } \
          \
        const bool grow_ = __any(pmax > m_reg + 8.0f); \
        const float mn = grow_ ? fmaxf(m_reg, pmax) : m_reg; const float alpha = grow_ ? __builtin_amdgcn_exp2f(m_reg - mn) : 1.0f; m_reg = mn; \
        float ps = 0.f; \
        _Pragma("unroll") for (int r = 0; r < 16; ++r) { p0[r] = __builtin_amdgcn_exp2f(p0[r] - mn); ps += p0[r]; } \
        _Pragma("unroll") for (int r = 0; r < 16; ++r) { p1[r] = __builtin_amdgcn_exp2f(p1[r] - mn); ps += p1[r]; } \
        { auto rr = __builtin_amdgcn_permlane32_swap(__float_as_uint(ps), __float_as_uint(ps), false, false); ps = __uint_as_float(rr[0]) + __uint_as_float(rr[1]); } \
        l_reg = l_reg * alpha + ps; \
        PK4(p0, 0, pa0); PK4(p0, 8, pa1); PK4(p1, 0, pa2); PK4(p1, 8, pa3); \
        if (grow_) { if (hi == 0) al_l[r32] = alpha; asm volatile("s_waitcnt lgkmcnt(0)" ::: "memory"); \
            _Pragma("unroll") for (int d_ = 0; d_ < 4; ++d_) _Pragma("unroll") for (int r = 0; r < 16; ++r) o[d_][r] *= al_l[crow(r, hi)]; } \
        MBAR(); } while (0)
    qkt(p0, p1, K_lds + kcur, koff, qr);
    VMW0(); MBAR();
    for (int t = 0; t + 1 < NT; ++t) {
        VALU_HALF(t);
        kcur = (kcur == 2 * SHM_K) ? 0 : kcur + SHM_K; kp2 = (kp2 == 2 * SHM_K) ? 0 : kp2 + SHM_K;
        pv_tile(o, vb0 + vcur, pa0, pa1, pa2, pa3);
        qkt(p0, p1, K_lds + kcur, koff, qr);
        VMW0(); MBAR();
        vcur = vnext; vnext = (vnext == 2 * SHM_V) ? 0 : vnext + SHM_V;
    }
    VALU_HALF(NT - 1);
    pv_tile(o, vb0 + vcur, pa0, pa1, pa2, pa3);
    MBAR();
    if (grp == 0) MBAR();
#undef VALU_HALF
#undef DMAK
#undef DMAV
#undef VMW0
    { int le = lane; asm volatile("" : "+v"(le)); const int r32e = le & 31, hie = le >> 5;
      if (hie == 0) li_l[r32e] = l_reg; asm volatile("s_waitcnt lgkmcnt(0)" ::: "memory");
#pragma unroll
      for (int r = 0; r < 16; ++r) { const size_t row = tb + qlo + crow(r, hie); const float rl = __builtin_amdgcn_rcpf(li_l[crow(r, hie)]);
#pragma unroll
        for (int d0 = 0; d0 < 4; ++d0) { const int col = h * 128 + d0 * 32 + r32e;
            const float g = bf2f(U[row * UCOLS + 1088 + col]);
            OG[row * DM + col] = f2bf(o[d0][r] * rl * silu_f(g)); } } }
    MBAR();
}
__device__ __forceinline__ void phase(unsigned char* ws, char* lds, int wid) {
    const int G = gridDim.x, bx = blockIdx.x; const int vcu = (G % 8 == 0) ? (bx % 8) * (G / 8) + bx / 8 : bx;
    int grp;
    { unsigned* cnt = (unsigned*)(lds + OFF_WS + 2048);
      const int lane0 = lane_id();
      if (wid == 0 && lane0 < 4) cnt[lane0] = 0u;
      __syncthreads();
      const unsigned simd = (unsigned)__builtin_amdgcn_s_getreg((1 << 11) | (4 << 6) | 4) & 3u;
      unsigned g = 0u; if (lane0 == 0) g = atomicAdd(&cnt[simd], 1u);
      grp = (int)(__builtin_amdgcn_readfirstlane(g) & 1u);
      __syncthreads(); }
    for (int L = vcu; L < 1024; L += G) { const int bh = L >> 5, x = L & 31;
        for (int pass = 0; pass < 2; ++pass) block(bh >> 4, bh & 15, pass ? x : 63 - x, ws, lds, grp, wid);     }
}
}

namespace dil {
__device__ __forceinline__ void wave_item(int w, int gi, const bf16* Gb, const float* gqn, const float* gkn, bf16* OP, float* LSE, char* wlds, int lane) {
    const int r32 = lane & 31, hi = lane >> 5;
    const int sb = w & 511, grp = w >> 9, br = grp % 3, hh = (grp / 3) & 3, b = grp / 12;
    const int dsh = 2 * br, d = 1 << dsh;
    const int nblk = 512 >> dsh, res = sb / nblk, blk = sb % nblk, n0 = blk * 32;
    const size_t tb = (size_t)b * SEQ;
    const int hcol = hh * 1152 + br * 128;
    float* rk_l = (float*)(wlds + 8192); float* al_l = rk_l + 32; float* li_l = al_l + 32;
    const int vb0 = (int)(uintptr_t)wlds + v_rd_base(lane);
    bf16x8 qr[8];
    { const bf16* qp = Gb + (tb + (size_t)(n0 + r32) * d + res) * GCOLS + hcol + hi * 8;
#pragma unroll
      for (int d0 = 0; d0 < 8; ++d0) qr[d0] = *(const bf16x8*)(qp + d0 * 16); }
    const int hg = gi * 4 + hh;
    const float ab = exp2f(-0.5f * (float)(hg + 1)) * (float)d * LOG2E;
    float m_reg = -1e30f, l_reg = 0.f; f32x16 o[4] = {};
    const int jfirst = n0 >= 128 ? 0 : ((128 - n0) >> 5);
    const bf16* kcol = Gb + hcol + 384 + hi * 8; const bf16* vcol = Gb + hcol + 768 + (lane & 15) * 8;
    bf16x8 kf[8]; u32x4 vv[8];
#define DIL_LOAD(j_) do { const int kb_ = n0 - 128 + 32 * (j_); \
        { int nk = kb_ + r32; nk = nk < 0 ? 0 : nk; const bf16* kp = kcol + (tb + (size_t)nk * d + res) * GCOLS; \
          _Pragma("unroll") for (int d0 = 0; d0 < 8; ++d0) kf[d0] = *(const bf16x8*)(kp + d0 * 16); } \
        _Pragma("unroll") for (int i = 0; i < 8; ++i) { int nk = kb_ + (lane >> 4) + 4 * i; nk = nk < 0 ? 0 : nk; \
            vv[i] = *(const u32x4*)(vcol + (tb + (size_t)nk * d + res) * GCOLS); } } while (0)
    DIL_LOAD(jfirst);
    for (int j = jfirst; j < 5; ++j) {
        const int kbase = n0 - 128 + 32 * j;
#pragma unroll
        for (int i = 0; i < 8; ++i) *(u32x4*)(wlds + v_st((lane >> 4) + 4 * i, (lane & 15) * 8)) = vv[i];
        f32x16 p0 = f32x16{};
#pragma unroll
        for (int d0 = 0; d0 < 8; ++d0) p0 = __builtin_amdgcn_mfma_f32_32x32x16_bf16(kf[d0], qr[d0], p0, 0, 0, 0);
        SBAR();
        if (j + 1 < 5) DIL_LOAD(j + 1);
        SBAR();
        asm volatile("s_waitcnt lgkmcnt(0)" ::: "memory");
        const float NEG = -__builtin_inff();
        float pmax = NEG;
#pragma unroll
        for (int r = 0; r < 16; ++r) { const int kc = crow(r, hi); const int nk = kbase + kc; const int rel = n0 + r32 - nk;
            float sv = p0[r] - ab * (float)rel;
            if (rel < 0 || rel > 128 || nk < 0) sv = NEG;
            p0[r] = sv; pmax = fmaxf(pmax, sv); }
        { auto rr = __builtin_amdgcn_permlane32_swap(__float_as_uint(pmax), __float_as_uint(pmax), false, false); pmax = fmaxf(__uint_as_float(rr[0]), __uint_as_float(rr[1])); }
        const float mn = fmaxf(m_reg, pmax); const float alpha = __builtin_amdgcn_exp2f(m_reg - mn); m_reg = mn;
        float ps = 0.f;
#pragma unroll
        for (int r = 0; r < 16; ++r) { p0[r] = __builtin_amdgcn_exp2f(p0[r] - mn); ps += p0[r]; }
        { auto rr = __builtin_amdgcn_permlane32_swap(__float_as_uint(ps), __float_as_uint(ps), false, false); ps = __uint_as_float(rr[0]) + __uint_as_float(rr[1]); }
        l_reg = l_reg * alpha + ps;
        bf16x8 pa0, pa1; PK4(p0, 0, pa0); PK4(p0, 8, pa1);
        if (__any(alpha < 1.f)) { if (hi == 0) al_l[r32] = alpha; asm volatile("s_waitcnt lgkmcnt(0)" ::: "memory");
#pragma unroll
            for (int d_ = 0; d_ < 4; ++d_)
#pragma unroll
                for (int r = 0; r < 16; ++r) o[d_][r] *= al_l[crow(r, hi)]; }
#define PV2(d0) do { s16x4 l0, l1, h0, h1; constexpr int b_ = (d0) * 512; \
        TRRD(l0, b_); TRRD(h0, b_ + 2048); TRRD(l1, b_ + 4096); TRRD(h1, b_ + 6144); \
        asm volatile("s_waitcnt lgkmcnt(0)" ::: "memory"); SBAR(); \
        o[d0] = __builtin_amdgcn_mfma_f32_32x32x16_bf16(pa0, (bf16x8){l0[0], l0[1], l0[2], l0[3], h0[0], h0[1], h0[2], h0[3]}, o[d0], 0, 0, 0);   \
        o[d0] = __builtin_amdgcn_mfma_f32_32x32x16_bf16(pa1, (bf16x8){l1[0], l1[1], l1[2], l1[3], h1[0], h1[1], h1[2], h1[3]}, o[d0], 0, 0, 0); } while (0)
        PV2(0); PV2(1); PV2(2); PV2(3);
#undef PV2
    }
#undef DIL_LOAD
    if (hi == 0) { li_l[r32] = l_reg; LSE[((size_t)br * NTOK + tb + (size_t)(n0 + r32) * d + res) * 4 + hh] = m_reg + __builtin_amdgcn_logf(l_reg); }
    asm volatile("s_waitcnt lgkmcnt(0)" ::: "memory");
    bf16* op = OP + (size_t)br * NTOK * 512;
    float rl[16];
#pragma unroll
    for (int r = 0; r < 16; ++r) rl[r] = __builtin_amdgcn_rcpf(li_l[crow(r, hi)]);
    asm volatile("s_waitcnt lgkmcnt(0)" ::: "memory");
#pragma unroll
    for (int r = 0; r < 16; ++r) { const int qc = crow(r, hi);
#pragma unroll
        for (int d0 = 0; d0 < 4; ++d0) *(unsigned short*)(wlds + qc * 272 + (d0 * 32 + r32) * 2) = f2bf(o[d0][r] * rl[r]); }
    asm volatile("s_waitcnt lgkmcnt(0)" ::: "memory");
#pragma unroll
    for (int i = 0; i < 8; ++i) { const int q = (lane >> 4) + 4 * i; const u32x4 v = *(const u32x4*)(wlds + q * 272 + (lane & 15) * 16);
        const size_t row = tb + (size_t)(n0 + q) * d + res; *(u32x4*)(op + row * 512 + hh * 128 + (lane & 15) * 8) = v; }
    asm volatile("s_waitcnt lgkmcnt(0)" ::: "memory");
}
}

__global__ void __launch_bounds__(512, 2) yoco_fwd(Args args) {
    extern __shared__ __attribute__((aligned(16))) unsigned char lds[];
    cg::grid_group grid = cg::this_grid();
    const int wave = __builtin_amdgcn_readfirstlane((int)threadIdx.x >> 6);
#define lane lane_id()
    const int G = gridDim.x; const int gw = blockIdx.x * 8 + wave, ngw = G * 8;
    unsigned char* ws = args.ws;
    const int lo = args.ph_lo, hi = args.ph_hi;
#define IN(k) (lo <= (k) && (k) < hi)
#define SEAM(k) do { if ((k) + 1 < hi) grid.sync(); } while (0)
    if (IN(0)) {
      for (int rep = 0; rep < (DUP == 100 ? 2 : 1); ++rep) {
        LAS float* scr = (LAS float*)((LAS unsigned char*)lds + wave * 16384);
        int base = 0;
#define TR_MAT(Wp, Kc, Nc, Gp, Tp, Mp) do { const int ni = ((Kc) / 64) * ((Nc) / 32); int first = (gw - base) % ngw; if (first < 0) first += ngw; \
            for (int it = first; it < ni; it += ngw) transpose_item((Wp), (Kc), (Nc), (Gp), (Tp), (Mp), scr, it, lane); base += ni; } while (0)
        TR_MAT(args.in[2], 2048, 3136, args.in[1], (bf16*)(ws + WS_WAIN), 0);
        TR_MAT(args.in[4], 512, 3072, args.in[3], (bf16*)(ws + WS_WQUP), 0);
        TR_MAT(args.in[6], 512, 4096, args.in[5], (bf16*)(ws + WS_WKVUP), 0);
        TR_MAT(args.in[9], 2048, 2048, (const float*)nullptr, (bf16*)(ws + WS_WAO), 0);
        TR_MAT(args.in[11], 2048, 12288, args.in[10], (bf16*)(ws + WS_WBALL), 1);
        TR_MAT(args.in[14], 2048, 8192, args.in[13], (bf16*)(ws + WS_WBALL), 2);
        TR_MAT(args.in[16], 2048, 2048, (const float*)nullptr, (bf16*)(ws + WS_WBO), 0);
#undef TR_MAT
        if (NTOK % (4 * ngw) == 0) { for (int m = gw; m < NTOK; m += 4 * ngw) norm_row4_nt<true>(args.in[0] + (size_t)m * DM, (bf16*)(ws + WS_XN) + (size_t)m * DM, (size_t)ngw * DM, lane); }
        else { for (int m = gw; m < NTOK; m += ngw) norm_row(args.in[0] + (size_t)m * DM, (bf16*)(ws + WS_XN) + (size_t)m * DM, lane); }
        { float* COS = (float*)(ws + WS_ROPE); float* SIN = COS + SEQ * 32;
          for (int idx = gw * 64 + lane; idx < SEQ * 32; idx += ngw * 64) { float c, sn; sincos_pos(idx >> 5, idx & 31, c, sn); COS[idx] = c; SIN[idx] = sn; } }
      }
        SEAM(0);
    }
    if (IN(1)) {
        const pg8::Gemm g{(bf16*)(ws + WS_XN), (bf16*)(ws + WS_WAIN), NTOK, UCOLS, 2048, 2048};
        const pg8::EpiSt E{(bf16*)(ws + WS_U), UCOLS, 1 << 30, nullptr, 0, 0};
        pg8::StaticOrder S; S.init(g.M, g.N, G, (int)blockIdx.x);
#ifndef SK_G1
        for (int rep = 0; rep < (DUP == 1 ? 2 : 1); ++rep)
        pg8::gemm_phase<pg8::EpiSt, pg8::StaticOrder, true, true, 2048, 2048>((LAS unsigned char*)lds, g, S, E, wave);
#endif
        SEAM(1);
    }
    if (IN(2)) {
        for (int cj = 0; cj < (DUP == 2 ? 4 : 2); ++cj) { const int ci = cj & 1;
            const pg8::Gemm g{(bf16*)(ws + WS_U) + (ci ? 512 : 0), (bf16*)(ws + (ci ? WS_WKVUP : WS_WQUP)), NTOK, ci ? KVCOLS : QCOLS, 512, UCOLS};
            const pg8::EpiSt E{(bf16*)(ws + (ci ? WS_KV : WS_Q)), ci ? KVCOLS : QCOLS, 1 << 30, nullptr, 0, 0};
            pg8::StaticOrder S; S.init(g.M, g.N, G, (int)blockIdx.x);
#ifndef SK_G1
            pg8::gemm_phase<pg8::EpiSt, pg8::StaticOrder, true, true, 512, UCOLS>((LAS unsigned char*)lds, g, S, E, wave);
#endif
        }
        SEAM(2);
    }
    if (IN(3)) {
#ifndef SK_QKN
        { int l3 = lane; asm volatile("" : "+v"(l3)); qknorm_phase(ws, args.in[7], args.in[8], gw, ngw, l3); }
#endif
        SEAM(3);
    }
    if (IN(4)) {
#ifndef SK_MLA
        for (int rep = 0; rep < (DUP == 4 ? 2 : 1); ++rep) mla::phase(ws, (char*)lds, wave);
#endif
        SEAM(4);
    }
    if (IN(5)) {
        const pg8::Gemm g{(bf16*)(ws + WS_XN), (bf16*)(ws + WS_WAO), NTOK, DM, 2048, 2048};
        const pg8::EpiRes E{args.in[0], args.out, DM, true, false};
        pg8::StaticOrder S; S.init(g.M, g.N, G, (int)blockIdx.x);
#ifndef SK_G2
        for (int rep = 0; rep < (DUP == 5 ? 2 : 1); ++rep)
        pg8::gemm_phase<pg8::EpiRes, pg8::StaticOrder, true, true, 2048, 2048>((LAS unsigned char*)lds, g, S, E, wave);
#endif
        SEAM(5);
    }
    if (IN(6)) {
        if (DUP == 66) { for (int rep = 0; rep < 20; ++rep) grid.sync(); }
        for (int rep = 0; rep < (DUP == 6 ? 2 : 1); ++rep)
        if (NTOK % (4 * ngw) == 0) { for (int m = gw; m < NTOK; m += 4 * ngw) norm_row4_nt<false>(args.out + (size_t)m * DM, (bf16*)(ws + WS_XN) + (size_t)m * DM, (size_t)ngw * DM, lane); }
        else { for (int m = gw; m < NTOK; m += ngw) norm_row(args.out + (size_t)m * DM, (bf16*)(ws + WS_XN) + (size_t)m * DM, lane); }
        SEAM(6);
    }
    for (int it = 0; it < (DUP == 7 ? 8 : 4); ++it) { const int gi = it & 3;
        if (IN(7 + 3 * gi)) {
            const pg8::Gemm g{(bf16*)(ws + WS_XN), (bf16*)(ws + WS_WBALL) + (size_t)gi * GN * 2048, NTOK, GN, 2048, 2048};
            const pg8::EpiStNorm E{(bf16*)(ws + WS_G), GCOLS, 18, (bf16*)(ws + WS_GATE), DM, gi * 512, args.in[15], args.in[12], (LAS float*)((LAS unsigned char*)lds + 131072), QSCALE_B, EPSN};
            pg8::StaticOrder S; S.init(g.M, g.N, G, (int)blockIdx.x);
#ifndef SK_G1
            pg8::gemm_phase<pg8::EpiStNorm, pg8::StaticOrder, true, true, 2048, 2048>((LAS unsigned char*)lds, g, S, E, wave);
#endif
            SEAM(7 + 3 * gi);
        }
        if (IN(8 + 3 * gi)) {
#ifndef SK_DIL
            int lane2 = lane; asm volatile("" : "+v"(lane2));
            char* wlds = (char*)lds + wave * 16384;
            const int gwx = (G % 8 == 0) ? ((int)(blockIdx.x & 7) * (G / 8) + (int)(blockIdx.x >> 3)) * 8 + wave : gw;
            for (int rep = 0; rep < (DUP == 8 ? 2 : 1); ++rep)
            for (int w = gwx; w < 12288; w += ngw)
                dil::wave_item(w, gi, (const bf16*)(ws + WS_G), args.in[15], args.in[12], (bf16*)(ws + WS_OP), (float*)(ws + WS_LSE), wlds, lane2);
#endif
            SEAM(8 + 3 * gi);
        }
        if (IN(9 + 3 * gi)) {
            int lane2 = lane; asm volatile("" : "+v"(lane2));
            const int hh = lane2 >> 4, e0 = 8 * (lane2 & 15);
            const bf16* OP = (const bf16*)(ws + WS_OP); const float* LSE = (const float*)(ws + WS_LSE);
            const bf16* GATE = (const bf16*)(ws + WS_GATE); bf16* OG = (bf16*)(ws + WS_OG);
            for (int t0 = gw; t0 < NTOK; t0 += 4 * ngw) {
                float ls[4][3]; u32x4 ov[4][3], gv[4]; size_t oc[4]; bool ok[4];
#pragma unroll
                for (int k = 0; k < 4; ++k) { const int t = t0 + k * ngw; ok[k] = t < NTOK; const int tc = ok[k] ? t : t0;
                    oc[k] = (size_t)tc * DM + (gi * 4 + hh) * 128 + e0;
#pragma unroll
                    for (int br = 0; br < 3; ++br) { ls[k][br] = __builtin_nontemporal_load(LSE + ((size_t)br * NTOK + tc) * 4 + hh); ov[k][br] = __builtin_nontemporal_load((const u32x4*)(OP + ((size_t)br * NTOK + tc) * 512 + hh * 128 + e0)); }
                    gv[k] = __builtin_nontemporal_load((const u32x4*)(GATE + oc[k])); }
#pragma unroll
                for (int k = 0; k < 4; ++k) {
                    const float mx = fmaxf(ls[k][0], fmaxf(ls[k][1], ls[k][2]));
                    float w0 = __builtin_amdgcn_exp2f(ls[k][0] - mx), w1 = __builtin_amdgcn_exp2f(ls[k][1] - mx), w2 = __builtin_amdgcn_exp2f(ls[k][2] - mx);
                    const float inv = __builtin_amdgcn_rcpf(w0 + w1 + w2); w0 *= inv; w1 *= inv; w2 *= inv;
                    u32x4 res;
#pragma unroll
                    for (int j = 0; j < 4; ++j) {
                        const float a = w0 * bflo(ov[k][0][j]) + w1 * bflo(ov[k][1][j]) + w2 * bflo(ov[k][2][j]);
                        const float c = w0 * bfhi(ov[k][0][j]) + w1 * bfhi(ov[k][1][j]) + w2 * bfhi(ov[k][2][j]);
                        res[j] = cvtpk(a * silu_f(bflo(gv[k][j])), c * silu_f(bfhi(gv[k][j]))); }
                    if (ok[k]) *(u32x4*)(OG + oc[k]) = res; }
            }
            if (gi == 3) SEAM(9 + 3 * gi);
        }
    }
    if (IN(19)) {
        const pg8::Gemm g{(bf16*)(ws + WS_OG), (bf16*)(ws + WS_WBO), NTOK, DM, 2048, 2048};
        const pg8::EpiRes E{args.out, args.out, DM, true, true};
        pg8::StaticOrder S; S.init(g.M, g.N, G, (int)blockIdx.x);
#ifndef SK_G2
        pg8::gemm_phase<pg8::EpiRes, pg8::StaticOrder, true, true, 2048, 2048>((LAS unsigned char*)lds, g, S, E, wave);
#endif
    }
#undef IN
#undef SEAM
#undef lane
}

#ifndef ONE_LAUNCH
#define ONE_LAUNCH 1
#endif
extern "C" void kernel_launch(void* const* d_in, const int* in_sizes, int n_in, void* d_out, int out_size, void* d_ws, size_t ws_size, hipStream_t stream) {
    static int grid = 0;
    if (grid == 0) {
        if (n_in != 17 || in_sizes[0] != NTOK * DM || out_size != NTOK * DM || ws_size < WS_END) {
            fprintf(stderr, "kernel_launch: unexpected shapes (n_in %d, in0 %d, out %d, ws %zu < %zu)\n", n_in, n_in > 0 ? in_sizes[0] : -1, out_size, ws_size, (size_t)WS_END); grid = -1; return; }
        int dev = 0, cus = 0, per_cu = 0;
        (void)hipGetDevice(&dev); (void)hipDeviceGetAttribute(&cus, hipDeviceAttributeMultiprocessorCount, dev);
        if (hipFuncSetAttribute((const void*)yoco_fwd, hipFuncAttributeMaxDynamicSharedMemorySize, LDS_BYTES) != hipSuccess) { fprintf(stderr, "kernel_launch: hipFuncSetAttribute failed\n"); grid = -1; return; }
        (void)hipOccupancyMaxActiveBlocksPerMultiprocessor(&per_cu, (const void*)yoco_fwd, 512, LDS_BYTES);
        (void)hipGetLastError();
        if (per_cu < 1) per_cu = 1;
        grid = cus > 0 ? cus : 256;
    }
    if (grid < 0) return;
    Args a{};
    for (int i = 0; i < 17; ++i) a.in[i] = (const float*)d_in[i];
    a.out = (float*)d_out; a.ws = (unsigned char*)d_ws;
#if ONE_LAUNCH
    a.ph_lo = 0; a.ph_hi = NPHASE;
    void* kargs[] = {&a};
    hipError_t e = hipLaunchCooperativeKernel((const void*)yoco_fwd, dim3(grid), dim3(512), kargs, LDS_BYTES, stream);
    if (e != hipSuccess) fprintf(stderr, "cooperative launch failed: %s (grid %d)\n", hipGetErrorString(e), grid);
#else
    for (int ph = 0; ph < NPHASE; ++ph) { a.ph_lo = ph; a.ph_hi = ph + 1;
        hipLaunchKernelGGL(yoco_fwd, dim3(grid), dim3(512), LDS_BYTES, stream, a); }
#endif
}
```
